# Optimizing an MI355X kernel written in HIP

```python
import math
import jax, jax.numpy as jnp
from jax import lax
import numpy as np

D_MODEL = 2048
BATCH = 4
SEQ = 8192
DEPTH = 1

N_META = 16
CONV_K = 4
GDN_HEADS = 8
GDN_DK = 128
GDN_DV = 128
GDN_CHUNK = 64
GLA_HEADS = 4
GLA_DK = 128
GLA_DV = 256
GLA_CHUNK = 16
GLA_GATE_RANK = 16
GLA_GATE_NORMALIZER = 16.0
GDN_QK = GDN_HEADS * GDN_DK
GDN_V = GDN_HEADS * GDN_DV
GLA_QK = GLA_HEADS * GLA_DK
GLA_V = GLA_HEADS * GLA_DV
MIX_WIDTH = GDN_V + GLA_V
D_FF = -(-8 * D_MODEL // (3 * 256)) * 256
IN_SPLITS = (2 * GDN_QK + GDN_V, GDN_V, GDN_HEADS, GDN_HEADS, GLA_QK, GLA_QK, GLA_V, GLA_V, GLA_GATE_RANK)
D_IN = sum(IN_SPLITS)
IN_OFFSETS = tuple(int(i) for i in np.cumsum(IN_SPLITS)[:-1])
NORM_EPS = 1e-6

kernel_name = "hybrid_gdn_gla_meta_block"


def rms_norm(x, w):
    xf = x.astype(jnp.float32)
    y = xf * lax.rsqrt(jnp.mean(xf * xf, axis=-1, keepdims=True) + NORM_EPS)
    return (y * w.astype(jnp.float32)).astype(x.dtype)


def l2_normalize(x):
    xf = x.astype(jnp.float32)
    return (xf * lax.rsqrt(jnp.sum(xf * xf, axis=-1, keepdims=True) + NORM_EPS)).astype(x.dtype)


def causal_short_conv(x, w):
    L = x.shape[1]
    xp = jnp.pad(x, ((0, 0), (CONV_K - 1, 0), (0, 0)))
    y = xp[:, 0:L] * w[0]
    for i in range(1, CONV_K):
        y = y + xp[:, i:i + L] * w[i]
    return jax.nn.silu(y)


def to_chunks(t, chunk, pad):
    t = jnp.pad(t, ((0, 0), (pad, 0), (0, 0), (0, 0)))
    b, lp, h, d = t.shape
    return t.reshape(b, lp // chunk, chunk, h, d).transpose(0, 3, 1, 2, 4)


def from_chunks(o, pad):
    b, h, n, c, d = o.shape
    return o.transpose(0, 2, 3, 1, 4).reshape(b, n * c, h, d)[:, pad:]


def gated_delta_rule(q, k, v, beta, g):
    out_dtype = v.dtype
    f32 = jnp.float32
    C = GDN_CHUNK
    pad = (-N_META) % C
    q, k, v = (to_chunks(t.astype(f32), C, pad) for t in (q, k, v))
    beta, g = (to_chunks(t.astype(f32)[..., None], C, pad)[..., 0] for t in (beta, g))
    gc = jnp.cumsum(g, axis=-1)
    causal = jnp.tril(jnp.ones((C, C), bool))
    strict = jnp.tril(jnp.ones((C, C), bool), -1)
    decay = jnp.exp(jnp.where(causal, gc[..., :, None] - gc[..., None, :], -jnp.inf))
    kb = k * beta[..., None]
    a_low = jnp.where(strict, jnp.einsum('bhncd,bhnsd->bhncs', kb, k) * decay, 0.0)
    t_mat = a_low + jnp.eye(C, dtype=f32)
    u = lax.linalg.triangular_solve(t_mat, v * beta[..., None], left_side=True, lower=True, unit_diagonal=True)
    w = lax.linalg.triangular_solve(t_mat, kb * jnp.exp(gc)[..., None], left_side=True, lower=True, unit_diagonal=True)
    qk = jnp.einsum('bhncd,bhnsd->bhncs', q, k) * decay
    q_dec = q * jnp.exp(gc)[..., None]
    k_dec = k * jnp.exp(gc[..., -1:] - gc)[..., None]
    g_last = jnp.exp(gc[..., -1])

    def step(S, inp):
        qd, kd, u_c, w_c, qk_c, gl = inp
        v_new = u_c - jnp.einsum('bhcd,bhde->bhce', w_c, S)
        o = jnp.einsum('bhcd,bhde->bhce', qd, S) + jnp.einsum('bhcs,bhse->bhce', qk_c, v_new)
        S = S * gl[..., None, None] + jnp.einsum('bhcd,bhce->bhde', kd, v_new)
        return S, o

    xs = tuple(jnp.moveaxis(t, 2, 0) for t in (q_dec, k_dec, u, w, qk, g_last))
    b, h = q.shape[0], q.shape[1]
    S0 = jnp.zeros((b, h, GDN_DK, GDN_DV), f32)
    _, o = lax.scan(step, S0, xs)
    return from_chunks(jnp.moveaxis(o, 0, 2), pad).astype(out_dtype)


def gla_chunked(q, k, v, log_a):
    out_dtype = v.dtype
    f32 = jnp.float32
    C = GLA_CHUNK
    pad = (-N_META) % C
    q, k, v, log_a = (to_chunks(t.astype(f32), C, pad) for t in (q, k, v, log_a))
    bcum = jnp.cumsum(log_a, axis=-2)
    causal = jnp.tril(jnp.ones((C, C), bool))

    def step(S, inp):
        q_c, k_c, v_c, b_c = inp
        diff = jnp.where(causal[..., None], b_c[..., :, None, :] - b_c[..., None, :, :], -jnp.inf)
        scores = jnp.einsum('bhid,bhjd,bhijd->bhij', q_c, k_c, jnp.exp(diff))
        o = jnp.einsum('bhid,bhde->bhie', q_c * jnp.exp(b_c), S) + jnp.einsum('bhij,bhje->bhie', scores, v_c)
        b_last = b_c[..., -1, :]
        S = S * jnp.exp(b_last)[..., None] + jnp.einsum(
            'bhjd,bhje->bhde', k_c * jnp.exp(b_last[..., None, :] - b_c), v_c)
        return S, o

    xs = tuple(jnp.moveaxis(t, 2, 0) for t in (q, k, v, bcum))
    b, h = q.shape[0], q.shape[1]
    S0 = jnp.zeros((b, h, GLA_DK, GLA_DV), f32)
    _, o = lax.scan(step, S0, xs)
    return from_chunks(jnp.moveaxis(o, 0, 2), pad).astype(out_dtype)


def setup_inputs(seed: int = 0) -> dict:
    key = jax.random.key(seed)
    ks = jax.random.split(key, 20)
    f32 = jnp.float32

    def nrm(k, shape, scale):
        return jax.random.normal(k, shape, f32) * scale

    def gain(k, shape):
        return 1.0 + 0.01 * jax.random.normal(k, shape, f32)

    dt = jnp.exp(jax.random.uniform(ks[7], (DEPTH, GDN_HEADS), f32, math.log(1e-3), math.log(1e-1)))
    return {
        "x": nrm(ks[0], (BATCH, SEQ, D_MODEL), 1.0),
        "meta_tokens": nrm(ks[1], (N_META, D_MODEL), 1.0),
        "attn_norm_w": gain(ks[2], (DEPTH, D_MODEL)),
        "w_in": nrm(ks[3], (DEPTH, D_MODEL, D_IN), D_MODEL ** -0.5),
        "gdn_conv_w": nrm(ks[4], (DEPTH, CONV_K, 2 * GDN_QK + GDN_V), CONV_K ** -0.5),
        "gdn_a_log": jnp.log(jax.random.uniform(ks[5], (DEPTH, GDN_HEADS), f32, 1.0, 16.0)),
        "gdn_dt_bias": dt + jnp.log(-jnp.expm1(-dt)),
        "gdn_norm_w": gain(ks[6], (DEPTH, GDN_DV)),
        "gla_gate_w2": nrm(ks[8], (DEPTH, GLA_GATE_RANK, GLA_QK), GLA_GATE_RANK ** -0.5),
        "gla_gate_b": nrm(ks[9], (DEPTH, GLA_QK), 0.01),
        "gla_norm_w": gain(ks[10], (DEPTH, GLA_DV)),
        "w_out": nrm(ks[11], (DEPTH, MIX_WIDTH, D_MODEL), MIX_WIDTH ** -0.5),
        "ffn_norm_w": gain(ks[12], (DEPTH, D_MODEL)),
        "w_gate": nrm(ks[13], (DEPTH, D_MODEL, D_FF), D_MODEL ** -0.5),
        "w_up": nrm(ks[14], (DEPTH, D_MODEL, D_FF), D_MODEL ** -0.5),
        "w_down": nrm(ks[15], (DEPTH, D_FF, D_MODEL), D_FF ** -0.5),
        "final_norm_w": gain(ks[16], (D_MODEL,)),
    }


def reference(x, meta_tokens, attn_norm_w, w_in, gdn_conv_w, gdn_a_log, gdn_dt_bias, gdn_norm_w,
              gla_gate_w2, gla_gate_b, gla_norm_w, w_out, ffn_norm_w, w_gate, w_up, w_down, final_norm_w):
    f32 = jnp.float32
    bsz = x.shape[0]
    meta = jnp.broadcast_to(meta_tokens.astype(x.dtype)[None], (bsz, N_META, D_MODEL))
    h = jnp.concatenate([meta, x], axis=1)
    L = h.shape[1]
    for layer in range(DEPTH):
        n = rms_norm(h, attn_norm_w[layer])
        proj = n @ w_in[layer]
        (gdn_qkv, gdn_z, gdn_a, gdn_b, gla_q, gla_k, gla_v, gla_r, gla_lr) = jnp.split(proj, IN_OFFSETS, axis=-1)

        qkv = causal_short_conv(gdn_qkv, gdn_conv_w[layer])
        q, k, v = jnp.split(qkv, (GDN_QK, 2 * GDN_QK), axis=-1)
        q = l2_normalize(q.reshape(bsz, L, GDN_HEADS, GDN_DK)) * (GDN_DK ** -0.5)
        k = l2_normalize(k.reshape(bsz, L, GDN_HEADS, GDN_DK))
        v = v.reshape(bsz, L, GDN_HEADS, GDN_DV)
        beta = jax.nn.sigmoid(gdn_b.astype(f32))
        g = -jnp.exp(gdn_a_log[layer].astype(f32)) * jax.nn.softplus(
            gdn_a.astype(f32) + gdn_dt_bias[layer].astype(f32))
        o_gdn = gated_delta_rule(q, k, v, beta, g)
        o_gdn = rms_norm(o_gdn, gdn_norm_w[layer]) * jax.nn.silu(gdn_z.reshape(bsz, L, GDN_HEADS, GDN_DV))

        gq = gla_q.reshape(bsz, L, GLA_HEADS, GLA_DK) * (GLA_DK ** -0.5)
        gk = gla_k.reshape(bsz, L, GLA_HEADS, GLA_DK)
        gv = gla_v.reshape(bsz, L, GLA_HEADS, GLA_DV)
        log_a = jax.nn.log_sigmoid((gla_lr @ gla_gate_w2[layer] + gla_gate_b[layer]).astype(f32)) / GLA_GATE_NORMALIZER
        o_gla = gla_chunked(gq, gk, gv, log_a.reshape(bsz, L, GLA_HEADS, GLA_DK))
        o_gla = rms_norm(o_gla, gla_norm_w[layer]) * jax.nn.silu(gla_r.reshape(bsz, L, GLA_HEADS, GLA_DV))

        mixed = jnp.concatenate([o_gdn.reshape(bsz, L, GDN_V), o_gla.reshape(bsz, L, GLA_V)], axis=-1)
        h = h + mixed @ w_out[layer]

        n = rms_norm(h, ffn_norm_w[layer])
        h = h + (jax.nn.silu(n @ w_gate[layer]) * (n @ w_up[layer])) @ w_down[layer]
    return rms_norm(h[:, N_META:], final_norm_w)
```

```cpp
#include <hip/hip_runtime.h>
#include <hip/hip_cooperative_groups.h>
#include <cstdio>
#include <cstdint>
namespace cg = cooperative_groups;
namespace pg8 {
#define PG8_LAS __attribute__((address_space(3)))
typedef unsigned short bf16_t;
typedef short bf16x8 __attribute__((ext_vector_type(8)));
typedef float f32x4 __attribute__((ext_vector_type(4)));
typedef unsigned u32x4 __attribute__((ext_vector_type(4)));
constexpr int BM = 256, BK = 64, HALF = 128, HTB = HALF * BK * 2  , STAGE_BYTES = 8 * HTB, NXCD = 8, WGM = 8;

__host__ __device__ __forceinline__ int lds_byte(int r, int c) { const int st = (r >> 4) * 2 + (c >> 5), rr = r & 15, cc = c & 31, ob = rr * 64 + cc * 2; return st * 1024 + (ob ^ (((ob >> 9) & 1) << 5)); }
__host__ __device__ __forceinline__ void stage_rc(int b, int& R, int& C) { const int st = b / 1024, sb = b % 1024, swz = sb ^ (((sb >> 9) & 1) << 5); R = (st >> 1) * 16 + swz / 64; C = (st & 1) * 32 + (swz % 64) / 2; }
__host__ __device__ __forceinline__ int perm32(int rho) { const int n = rho >> 4, i = rho & 15; return 8 * (i >> 2) + 4 * n + (i & 3); }

struct Unit { int pm, pn; };
struct Gemm { const bf16_t* A; const bf16_t* Bt; int M, N, K; };

struct StaticOrder {
    int nM, nN, nwg, G, c;
    __host__ __device__ void init(int M, int N, int G_, int c_) { nM = M / BM; nN = N / BM; nwg = nM * nN; G = G_; c = c_; }
    __host__ __device__ bool next(int i, Unit& u) const {
        const long L = (long)i * G + c; if (L >= nwg) return false;
        int wgid = (int)L; { const int q = nwg / NXCD, r = nwg % NXCD, xcd = wgid % NXCD, off = wgid / NXCD; wgid = (xcd < r ? xcd * (q + 1) : r * (q + 1) + (xcd - r) * q) + off; }
        const int nig = WGM * nN, gid = wgid / nig, fm = gid * WGM, gsz = (nM - fm) < WGM ? (nM - fm) : WGM;
        u.pm = fm + ((wgid % nig) % gsz); u.pn = (wgid % nig) / gsz; return true;
    }
    __device__ __forceinline__ void a_ready(const Unit&) const {}
    __device__ __forceinline__ void done(const Unit&) const {}
};

__device__ __forceinline__ unsigned cvt_pk_bf16(float lo, float hi) { unsigned r; asm volatile("v_cvt_pk_bf16_f32 %0, %1, %2" : "=v"(r) : "v"(lo), "v"(hi)); return r; }
typedef float f32x2 __attribute__((ext_vector_type(2)));
__device__ __forceinline__ float silu_f(float g) { return g * __builtin_amdgcn_rcpf(1.0f + __expf(-g)); }
struct EpiProj {
    static constexpr bool PERM = true, AFTER_DRAIN = false;
    bf16_t* O; float* Sm;
    __device__ __forceinline__ void operator()(const f32x4 (&acc)[2][2][4][2], const Unit& u, int wr, int wc, int fr, int fq) const {
        const int row0 = u.pm * BM + wr * 64 + fr;
        if (u.pn < 28) {
            const int col0 = u.pn * BM + wc * 32 + 8 * fq;
#pragma unroll
            for (int ai = 0; ai < 2; ++ai)
#pragma unroll
                for (int m = 0; m < 4; ++m) { bf16_t* rowp = O + (size_t)(row0 + ai * HALF + m * 16) * 7168 + col0;
#pragma unroll
                    for (int bj = 0; bj < 2; ++bj) { const f32x4 v0 = acc[ai][bj][m][0], v1 = acc[ai][bj][m][1];
                        u32x4 w; w.x = cvt_pk_bf16(v0[0], v0[1]); w.y = cvt_pk_bf16(v0[2], v0[3]); w.z = cvt_pk_bf16(v1[0], v1[1]); w.w = cvt_pk_bf16(v1[2], v1[3]);
                        *(u32x4*)(rowp + bj * HALF) = w; } }
        } else if (wc == 0) {
#pragma unroll
            for (int ai = 0; ai < 2; ++ai)
#pragma unroll
                for (int m = 0; m < 4; ++m) { float* rp = Sm + (size_t)(row0 + ai * HALF + m * 16) * 32 + 8 * fq;
                    *(f32x4*)rp = acc[ai][0][m][0]; *(f32x4*)(rp + 4) = acc[ai][0][m][1]; }
        }
    }
};
struct EpiRes {
    static constexpr bool PERM = true, AFTER_DRAIN = false;
    const float* base; float* out;
    __device__ __forceinline__ void operator()(const f32x4 (&acc)[2][2][4][2], const Unit& u, int wr, int wc, int fr, int fq) const {
        const int row0 = u.pm * BM + wr * 64 + fr, col0 = u.pn * BM + wc * 32 + 8 * fq;
#pragma unroll
        for (int ai = 0; ai < 2; ++ai)
#pragma unroll
            for (int m = 0; m < 4; ++m) { const size_t off = (size_t)(row0 + ai * HALF + m * 16) * 2048 + col0;
#pragma unroll
                for (int bj = 0; bj < 2; ++bj)
#pragma unroll
                    for (int n = 0; n < 2; ++n) { const f32x4 b4 = *(const f32x4*)(base + off + bj * HALF + 4 * n); *(f32x4*)(out + off + bj * HALF + 4 * n) = b4 + acc[ai][bj][m][n]; } }
    }
};
struct EpiSwiGLU {
    static constexpr bool PERM = true, AFTER_DRAIN = false;
    bf16_t* O;
    __device__ __forceinline__ void operator()(const f32x4 (&acc)[2][2][4][2], const Unit& u, int wr, int wc, int fr, int fq) const {
        const int row0 = u.pm * BM + wr * 64 + fr, col0 = u.pn * 128 + wc * 32 + 8 * fq;
#pragma unroll
        for (int ai = 0; ai < 2; ++ai)
#pragma unroll
            for (int m = 0; m < 4; ++m) { bf16_t* rowp = O + (size_t)(row0 + ai * HALF + m * 16) * 5632 + col0;
                const f32x4 g0 = acc[ai][0][m][0], g1 = acc[ai][0][m][1], u0 = acc[ai][1][m][0], u1 = acc[ai][1][m][1];
                u32x4 w; w.x = cvt_pk_bf16(silu_f(g0[0]) * u0[0], silu_f(g0[1]) * u0[1]); w.y = cvt_pk_bf16(silu_f(g0[2]) * u0[2], silu_f(g0[3]) * u0[3]);
                w.z = cvt_pk_bf16(silu_f(g1[0]) * u1[0], silu_f(g1[1]) * u1[1]); w.w = cvt_pk_bf16(silu_f(g1[2]) * u1[2], silu_f(g1[3]) * u1[3]);
                *(u32x4*)rowp = w; }
    }
};
struct EpiResF2B {
    static constexpr bool PERM = true, AFTER_DRAIN = false;
    const float* base; bf16_t* out; float* ssp;
    __device__ __forceinline__ void operator()(const f32x4 (&acc)[2][2][4][2], const Unit& u, int wr, int wc, int fr, int fq) const {
        const int row0 = u.pm * BM + wr * 64 + fr, col0 = u.pn * BM + wc * 32 + 8 * fq;
#pragma unroll
        for (int ai = 0; ai < 2; ++ai)
#pragma unroll
            for (int m = 0; m < 4; ++m) { const int row = row0 + ai * HALF + m * 16; const size_t off = (size_t)row * 2048 + col0; float ss = 0.f;
#pragma unroll
                for (int bj = 0; bj < 2; ++bj) { const f32x4 v0 = *(const f32x4*)(base + off + bj * HALF) + acc[ai][bj][m][0], v1 = *(const f32x4*)(base + off + bj * HALF + 4) + acc[ai][bj][m][1];
                    ss += (v0[0] * v0[0] + v0[1] * v0[1]) + (v0[2] * v0[2] + v0[3] * v0[3]) + (v1[0] * v1[0] + v1[1] * v1[1]) + (v1[2] * v1[2] + v1[3] * v1[3]);
                    u32x4 w; w.x = cvt_pk_bf16(v0[0], v0[1]); w.y = cvt_pk_bf16(v0[2], v0[3]); w.z = cvt_pk_bf16(v1[0], v1[1]); w.w = cvt_pk_bf16(v1[2], v1[3]);
                    *(u32x4*)(out + off + bj * HALF) = w; }
                ss += __shfl_xor(ss, 16); ss += __shfl_xor(ss, 32);
                if (fq == 0) ssp[(size_t)row * 32 + 4 * u.pn + wc] = ss; }
    }
};
struct EpiResB2B {
    static constexpr bool PERM = true, AFTER_DRAIN = false;
    const bf16_t* base; bf16_t* out;
    __device__ __forceinline__ void operator()(const f32x4 (&acc)[2][2][4][2], const Unit& u, int wr, int wc, int fr, int fq) const {
        const int row0 = u.pm * BM + wr * 64 + fr, col0 = u.pn * BM + wc * 32 + 8 * fq;
#pragma unroll
        for (int ai = 0; ai < 2; ++ai)
#pragma unroll
            for (int m = 0; m < 4; ++m) { const size_t off = (size_t)(row0 + ai * HALF + m * 16) * 2048 + col0;
#pragma unroll
                for (int bj = 0; bj < 2; ++bj) { const u32x4 b4 = *(const u32x4*)(base + off + bj * HALF);
                    const f32x4 v0 = (f32x4){__uint_as_float(b4.x << 16), __uint_as_float(b4.x & 0xffff0000u), __uint_as_float(b4.y << 16), __uint_as_float(b4.y & 0xffff0000u)} + acc[ai][bj][m][0];
                    const f32x4 v1 = (f32x4){__uint_as_float(b4.z << 16), __uint_as_float(b4.z & 0xffff0000u), __uint_as_float(b4.w << 16), __uint_as_float(b4.w & 0xffff0000u)} + acc[ai][bj][m][1];
                    u32x4 w; w.x = cvt_pk_bf16(v0[0], v0[1]); w.y = cvt_pk_bf16(v0[2], v0[3]); w.z = cvt_pk_bf16(v1[0], v1[1]); w.w = cvt_pk_bf16(v1[2], v1[3]);
                    *(u32x4*)(out + off + bj * HALF) = w; } }
    }
};
struct EpiSwiGLUr {
    static constexpr bool PERM = true, AFTER_DRAIN = false;
    bf16_t* O; const float* rstd;
    __device__ __forceinline__ void operator()(const f32x4 (&acc)[2][2][4][2], const Unit& u, int wr, int wc, int fr, int fq) const {
        const int row0 = u.pm * BM + wr * 64 + fr, col0 = u.pn * 128 + wc * 32 + 8 * fq;
#pragma unroll
        for (int ai = 0; ai < 2; ++ai)
#pragma unroll
            for (int m = 0; m < 4; ++m) { const int row = row0 + ai * HALF + m * 16; bf16_t* rowp = O + (size_t)row * 5632 + col0;
                const float rs = rstd[row];
                const f32x4 g0 = acc[ai][0][m][0] * rs, g1 = acc[ai][0][m][1] * rs, u0 = acc[ai][1][m][0] * rs, u1 = acc[ai][1][m][1] * rs;
                u32x4 w; w.x = cvt_pk_bf16(silu_f(g0[0]) * u0[0], silu_f(g0[1]) * u0[1]); w.y = cvt_pk_bf16(silu_f(g0[2]) * u0[2], silu_f(g0[3]) * u0[3]);
                w.z = cvt_pk_bf16(silu_f(g1[0]) * u1[0], silu_f(g1[1]) * u1[1]); w.w = cvt_pk_bf16(silu_f(g1[2]) * u1[2], silu_f(g1[3]) * u1[3]);
                *(u32x4*)rowp = w; }
    }
};
template <class Epi, class Sched, bool ALIGN_EPI = false, bool SP2 = false>
__device__ __forceinline__ void gemm_phase(PG8_LAS unsigned char* lds, const Gemm g, const Sched& S, const Epi& E) {
    const int tid = threadIdx.x, wid = __builtin_amdgcn_readfirstlane(tid >> 6), lane = tid & 63, wr = wid >> 2, wc = wid & 3, fr = lane & 15, fq = lane >> 4;
    const int K = g.K, nt = K / BK;
    unsigned voffA[2], voffB[2];
#pragma unroll
    for (int i = 0; i < 2; ++i) { int R, C; stage_rc(tid * 16 + i * 8192, R, C); const int Rb = Epi::PERM ? ((R & ~31) + perm32(R & 31)) : R;
        voffA[i] = (unsigned)(R * K + C) * 2u; voffB[i] = (unsigned)(Rb * K + C) * 2u; }
    const size_t kstep = (size_t)(BK * 2);
    const size_t hstep = (size_t)HALF * K * 2;
    const size_t tstep = 2 * hstep;
    const unsigned ldsw = (unsigned)wid * 1024u;
    const int aoff = lds_byte(wr * 64 + fr, fq * 8), boff = lds_byte(wc * 32 + fr, fq * 8);
#define PG8_SA(b, h) (((b) * 2 + (h)) * HTB)
#define PG8_SB(b, h) ((4 + (b) * 2 + (h)) * HTB)
#define PG8_STAGE(bufoff, gbase, voff) do { _Pragma("unroll") for (int _i = 0; _i < 2; ++_i) \
        __builtin_amdgcn_global_load_lds((const unsigned*)((const char*)(gbase) + (voff)[_i]), (PG8_LAS unsigned*)(lds + (bufoff) + ldsw + _i * 8192), 16, 0, 0); } while (0)
#define PG8_LDA(dst, b, h) do { _Pragma("unroll") for (int m = 0; m < 4; ++m) _Pragma("unroll") for (int k = 0; k < 2; ++k) dst[m][k] = *(const PG8_LAS bf16x8*)(lds + PG8_SA(b, h) + aoff + m * 2048 + k * 1024); } while (0)
#define PG8_LDB(dst, b, h) do { _Pragma("unroll") for (int n = 0; n < 2; ++n) _Pragma("unroll") for (int k = 0; k < 2; ++k) dst[n][k] = *(const PG8_LAS bf16x8*)(lds + PG8_SB(b, h) + boff + n * 2048 + k * 1024); } while (0)
#define PG8_MMA(ai, bj, At, Bt) do { __builtin_amdgcn_s_setprio(1); _Pragma("unroll") for (int m = 0; m < 4; ++m) _Pragma("unroll") for (int n = 0; n < 2; ++n) _Pragma("unroll") for (int k = 0; k < 2; ++k) \
        acc[ai][bj][m][n] = __builtin_amdgcn_mfma_f32_16x16x32_bf16(Bt[n][k], At[m][k], acc[ai][bj][m][n], 0, 0, 0); __builtin_amdgcn_s_setprio(0); } while (0)
#define PG8_WAIT_V(n) asm volatile("s_waitcnt vmcnt(" #n ")" ::: "memory")
#define PG8_WAIT_L(n) asm volatile("s_waitcnt lgkmcnt(" #n ")" ::: "memory")
#define PG8_BAR __builtin_amdgcn_s_barrier()
#define PG8_SCHED __builtin_amdgcn_sched_barrier(0)
    Unit cur, nxt; int ui = 0;
    if (!S.next(0, cur)) return;
    f32x4 acc[2][2][4][2];
#pragma unroll
    for (int a = 0; a < 2; ++a)
#pragma unroll
        for (int b = 0; b < 2; ++b)
#pragma unroll
            for (int m = 0; m < 4; ++m)
#pragma unroll
                for (int n = 0; n < 2; ++n) acc[a][b][m][n] = (f32x4){0.f, 0.f, 0.f, 0.f};
    bf16x8 At[4][2], B0[2][2], B1[2][2];
    const char* cA = (const char*)g.A + (size_t)cur.pm * tstep; const char* cB = (const char*)g.Bt + (size_t)cur.pn * tstep;
    S.a_ready(cur);
    if constexpr (SP2) {
        PG8_STAGE(PG8_SB(0, 0), cB, voffB); PG8_STAGE(PG8_SB(0, 1), cB + hstep, voffB); PG8_STAGE(PG8_SA(0, 0), cA, voffA); PG8_STAGE(PG8_SA(0, 1), cA + hstep, voffA);
        if (wr == 1) PG8_BAR;
        PG8_WAIT_V(2); PG8_BAR;
        PG8_STAGE(PG8_SB(1, 0), cB + kstep, voffB); PG8_STAGE(PG8_SA(1, 0), cA + kstep, voffA); PG8_STAGE(PG8_SB(1, 1), cB + hstep + kstep, voffB);
        PG8_WAIT_V(6); PG8_BAR;
    } else {
        PG8_STAGE(PG8_SB(0, 0), cB, voffB); PG8_STAGE(PG8_SA(0, 0), cA, voffA); PG8_STAGE(PG8_SB(0, 1), cB + hstep, voffB); PG8_STAGE(PG8_SA(0, 1), cA + hstep, voffA);
        if (wr == 1) PG8_BAR;
        PG8_WAIT_V(4); PG8_BAR;
        PG8_STAGE(PG8_SB(1, 0), cB + kstep, voffB); PG8_STAGE(PG8_SA(1, 0), cA + kstep, voffA); PG8_STAGE(PG8_SB(1, 1), cB + hstep + kstep, voffB);
        PG8_WAIT_V(6); PG8_BAR;
    }
    for (;;) {
        const bool has_next = S.next(ui + 1, nxt);
        const char* nA = has_next ? (const char*)g.A + (size_t)nxt.pm * tstep : cA; const char* nB = has_next ? (const char*)g.Bt + (size_t)nxt.pn * tstep : cB;
        for (int t = 0; t < nt; t += 2) {
            const bool last = (t == nt - 2);
            const char* a1 = cA + (size_t)(t + 1) * kstep;
            const char* a2 = last ? nA : cA + (size_t)(t + 2) * kstep; const char* b2 = last ? nB : cB + (size_t)(t + 2) * kstep;
            const char* a3 = a2 + kstep; const char* b3 = b2 + kstep;
            if (last && has_next) S.a_ready(nxt);
            if constexpr (SP2) {
            PG8_LDB(B0, 0, 0); PG8_LDB(B1, 0, 1); PG8_SCHED; PG8_LDA(At, 0, 0); PG8_STAGE(PG8_SA(1, 1), a1 + hstep, voffA);
            PG8_WAIT_V(8); PG8_WAIT_L(0); PG8_BAR; PG8_MMA(0, 0, At, B0); PG8_MMA(0, 1, At, B1); PG8_BAR; PG8_SCHED;
            PG8_LDA(At, 0, 1); PG8_STAGE(PG8_SB(0, 0), b2, voffB); PG8_STAGE(PG8_SB(0, 1), b2 + hstep, voffB); PG8_STAGE(PG8_SA(0, 0), a2, voffA);
            PG8_WAIT_V(8); PG8_WAIT_L(0); PG8_BAR; PG8_MMA(1, 0, At, B0); PG8_MMA(1, 1, At, B1); PG8_BAR; PG8_SCHED;
            PG8_LDB(B0, 1, 0); PG8_LDB(B1, 1, 1); PG8_SCHED; PG8_LDA(At, 1, 0); PG8_STAGE(PG8_SA(0, 1), a2 + hstep, voffA);
            PG8_WAIT_V(8); PG8_WAIT_L(0); PG8_BAR; PG8_MMA(0, 0, At, B0); PG8_MMA(0, 1, At, B1); PG8_BAR; PG8_SCHED;
            PG8_LDA(At, 1, 1); PG8_STAGE(PG8_SB(1, 0), b3, voffB); PG8_STAGE(PG8_SB(1, 1), b3 + hstep, voffB); PG8_STAGE(PG8_SA(1, 0), a3, voffA);
            PG8_WAIT_V(8); PG8_WAIT_L(0); PG8_BAR; PG8_MMA(1, 0, At, B0); PG8_MMA(1, 1, At, B1); PG8_BAR; PG8_SCHED;
            } else {
            PG8_LDB(B0, 0, 0); PG8_SCHED; PG8_LDA(At, 0, 0); PG8_STAGE(PG8_SA(1, 1), a1 + hstep, voffA);
            PG8_WAIT_L(8); PG8_BAR; PG8_WAIT_L(0); PG8_MMA(0, 0, At, B0); PG8_BAR; PG8_SCHED;
            PG8_LDB(B1, 0, 1); PG8_STAGE(PG8_SB(0, 0), b2, voffB);
            PG8_BAR; PG8_WAIT_L(0); PG8_MMA(0, 1, At, B1); PG8_BAR;
            PG8_LDA(At, 0, 1); PG8_STAGE(PG8_SA(0, 0), a2, voffA);
            PG8_BAR; PG8_WAIT_L(0); PG8_MMA(1, 0, At, B0); PG8_BAR; PG8_SCHED;
            PG8_STAGE(PG8_SB(0, 1), b2 + hstep, voffB);
            PG8_WAIT_V(6); PG8_BAR; PG8_MMA(1, 1, At, B1); PG8_BAR;
            PG8_LDB(B0, 1, 0); PG8_SCHED; PG8_LDA(At, 1, 0); PG8_STAGE(PG8_SA(0, 1), a2 + hstep, voffA);
            PG8_WAIT_L(8); PG8_BAR; PG8_WAIT_L(0); PG8_MMA(0, 0, At, B0); PG8_BAR; PG8_SCHED;
            PG8_LDB(B1, 1, 1); PG8_STAGE(PG8_SB(1, 0), b3, voffB);
            PG8_BAR; PG8_WAIT_L(0); PG8_MMA(0, 1, At, B1); PG8_BAR;
            PG8_LDA(At, 1, 1); PG8_STAGE(PG8_SA(1, 0), a3, voffA);
            PG8_BAR; PG8_WAIT_L(0); PG8_MMA(1, 0, At, B0); PG8_BAR; PG8_SCHED;
            PG8_STAGE(PG8_SB(1, 1), b3 + hstep, voffB);
            PG8_WAIT_V(6); PG8_BAR; PG8_MMA(1, 1, At, B1); PG8_BAR;
            }
        }
        if constexpr (ALIGN_EPI) { if (wr == 0) PG8_BAR; }
        if constexpr (!Epi::AFTER_DRAIN) { E(acc, cur, wr, wc, fr, fq); S.done(cur); }
        if (!has_next) break;
#pragma unroll
        for (int a = 0; a < 2; ++a)
#pragma unroll
            for (int b = 0; b < 2; ++b)
#pragma unroll
                for (int m = 0; m < 4; ++m)
#pragma unroll
                    for (int n = 0; n < 2; ++n) acc[a][b][m][n] = (f32x4){0.f, 0.f, 0.f, 0.f};
        cur = nxt; cA = nA; cB = nB; ++ui;
        if constexpr (ALIGN_EPI) { if (wr == 1) PG8_BAR; }
    }
    PG8_WAIT_V(0);
    if constexpr (!ALIGN_EPI) { if (wr == 0) PG8_BAR; }
    PG8_BAR;
    if constexpr (Epi::AFTER_DRAIN) { E.fused(acc, cur, wr, wc, fr, fq, lds, wid, lane); S.done(cur); }
#undef PG8_SA
#undef PG8_SB
#undef PG8_STAGE
#undef PG8_LDA
#undef PG8_LDB
#undef PG8_MMA
#undef PG8_WAIT_V
#undef PG8_WAIT_L
#undef PG8_BAR
#undef PG8_SCHED
}
}
constexpr int NB = 4, SEQ = 8192, NMETA = 16, DM = 2048, MX = NB * SEQ  , META0 = MX  , MP = 33024  ;
constexpr int NCH = 129;
constexpr int PROJ_LD = 7168, NIN_P = 7424, DFF = 5632;
constexpr float EPS = 1e-6f;
constexpr size_t MiB = 1u << 20;
constexpr size_t WS_SMALL = 0;
constexpr size_t WS_GL    = 5 * MiB;
constexpr size_t WS_WIN   = 6 * MiB;
constexpr size_t WS_WOUT  = WS_WIN + 29 * MiB;
constexpr size_t WS_WGU   = WS_WOUT + 8 * MiB;
constexpr size_t WS_WDN   = WS_WGU + 44 * MiB;
constexpr size_t WS_NBUF  = WS_WDN + 22 * MiB;
constexpr size_t WS_PROJ  = WS_NBUF + 129 * MiB;
constexpr size_t WS_GDN   = WS_PROJ + 452 * MiB;
constexpr size_t WS_END   = WS_GDN + 319 * MiB;
constexpr int GDN_ITEM = 80896, GLA_ITEM = 82432;
constexpr int P3_BUF = 67072;
static_assert((size_t)MP * PROJ_LD * 2 <= 452 * MiB && (size_t)4128 * GDN_ITEM <= 319 * MiB && (size_t)2064 * GLA_ITEM <= (size_t)MX * DM * 4 && WS_END <= 1024 * MiB, "ws map");
constexpr int LDS_BYTES = 147456 + 64;

#define DI __device__ __forceinline__
typedef unsigned short bf16;
typedef float f32x4 __attribute__((ext_vector_type(4)));
typedef float f32x16 __attribute__((ext_vector_type(16)));
typedef short bf16x8 __attribute__((ext_vector_type(8)));
typedef unsigned short u16x4 __attribute__((ext_vector_type(4)));
typedef unsigned u32x4 __attribute__((ext_vector_type(4)));
typedef unsigned u32x2 __attribute__((ext_vector_type(2)));
typedef float f32x2_t __attribute__((ext_vector_type(2)));
typedef __bf16 bf16x2_t __attribute__((ext_vector_type(2)));
DI unsigned pk2(float lo, float hi) { f32x2_t v = {lo, hi}; bf16x2_t b = __builtin_convertvector(v, bf16x2_t); return __builtin_bit_cast(unsigned, b); }
DI bf16 f2bf(float f) { return (bf16)(pk2(f, 0.f) & 0xffffu); }
DI float bf2f(bf16 b) { return __uint_as_float((unsigned)b << 16); }
DI float bflo(unsigned w) { return __uint_as_float(w << 16); }
DI float bfhi(unsigned w) { return __uint_as_float(w & 0xffff0000u); }
#define MFMA32(a, b, c) __builtin_amdgcn_mfma_f32_32x32x16_bf16((a), (b), (c), 0, 0, 0)
DI int crow(int reg, int hh) { return (reg & 3) + 8 * (reg >> 2) + 4 * hh; }
DI int perm16(int k) { return 8 * ((k >> 2) & 1) + 4 * (k >> 3) + (k & 3); }
DI float wave_sum(float v) {
#pragma unroll
    for (int o = 1; o < 64; o <<= 1) v += __shfl_xor(v, o);
    return v;
}
DI float xor1(float v) { return __int_as_float(__builtin_amdgcn_update_dpp(0, __float_as_int(v), 0xB1, 0xF, 0xF, true)); }
DI int row_of(int b, int p) { return p < NMETA ? META0 + b * NMETA + p : b * SEQ + p - NMETA; }
DI float sigmoid_f(float x) { return __builtin_amdgcn_rcpf(1.0f + __expf(-x)); }
DI float silu_f(float x) { return x * sigmoid_f(x); }
#define LDS_WAIT() asm volatile("s_waitcnt lgkmcnt(0)" ::: "memory")

struct Args { const float* in[17]; float* out; unsigned char* ws; int ph_lo, ph_hi; };

DI int map_row(int mode, int n) {
    if (mode == 0) return n < 4096 ? n : (n < 4112 ? 7168 + (n - 4096) : (n < 7184 ? n - 16 : n));
    if (mode == 1) return (n >> 7) * 256 + (n & 127);
    if (mode == 2) return (n >> 7) * 256 + 128 + (n & 127);
    return n;
}
DI void transpose_load(const float* W, int N, int item, int lane, float (&tv)[32]) {
    const int nblk = N / 32, kb = item / nblk, nb = item % nblk, k0 = 64 * kb, n0 = 32 * nb;
#pragma unroll
    for (int i = 0; i < 32; ++i) { const int kk = 2 * i + (lane >> 5); tv[i] = W[(size_t)(k0 + kk) * N + n0 + (lane & 31)]; }
}
DI void transpose_store(const float (&tv)[32], int K, int N, bf16* WT, int mode, float* scr, int item, int lane, const float* kscale) {
    const int nblk = N / 32, kb = item / nblk, nb = item % nblk, k0 = 64 * kb, n0 = 32 * nb;
#pragma unroll
    for (int i = 0; i < 32; ++i) { const int kk = 2 * i + (lane >> 5); scr[kk * 33 + (lane & 31)] = tv[i]; }
    LDS_WAIT();
    const int c = lane & 7;
#pragma unroll
    for (int j = 0; j < 4; ++j) { const int n = (lane >> 3) + 8 * j; const float* s = scr + (8 * c) * 33 + n;
        f32x4 k0v = {1.f, 1.f, 1.f, 1.f}, k1v = {1.f, 1.f, 1.f, 1.f};
        if (mode == 1 || mode == 2) { k0v = *(const f32x4*)(kscale + k0 + 8 * c); k1v = *(const f32x4*)(kscale + k0 + 8 * c + 4); }
        u32x4 o; o.x = pk2(s[0 * 33] * k0v.x, s[1 * 33] * k0v.y); o.y = pk2(s[2 * 33] * k0v.z, s[3 * 33] * k0v.w); o.z = pk2(s[4 * 33] * k1v.x, s[5 * 33] * k1v.y); o.w = pk2(s[6 * 33] * k1v.z, s[7 * 33] * k1v.w);
        *(u32x4*)(WT + (size_t)map_row(mode, n0 + n) * K + k0 + 8 * c) = o; }
    LDS_WAIT();
}
DI void p0_item(const Args& a, int it, const float*& W, bf16*& WT, int& K, int& N, int& mode, int& item) {
    constexpr int I_IN = 32 * 225, I_OUT = 32 * 64, I_G = 32 * 176;
    unsigned char* ws = a.ws;
    const int sel = it < I_IN ? 0 : (it < I_IN + I_OUT ? 1 : (it < I_IN + I_OUT + I_G ? 2 : (it < I_IN + I_OUT + 2 * I_G ? 3 : 4)));
    item = it - (sel == 0 ? 0 : (sel == 1 ? I_IN : (sel == 2 ? I_IN + I_OUT : (sel == 3 ? I_IN + I_OUT + I_G : I_IN + I_OUT + 2 * I_G))));
    W = sel == 0 ? a.in[3] : (sel == 1 ? a.in[11] : (sel == 2 ? a.in[13] : (sel == 3 ? a.in[14] : a.in[15])));
    WT = (bf16*)(ws + (sel == 0 ? WS_WIN : (sel == 1 ? WS_WOUT : (sel == 4 ? WS_WDN : WS_WGU))));
    K = sel == 4 ? DFF : DM; N = sel == 0 ? 7200 : ((sel == 1 || sel == 4) ? DM : DFF); mode = sel == 0 ? 0 : (sel == 2 ? 1 : (sel == 3 ? 2 : 3));
}
DI void rms_row_bf16(const float* xrow, const float* w, bf16* orow, int lane) {
    const f32x4* xr = (const f32x4*)xrow + lane; const f32x4* wr = (const f32x4*)w + lane;
    f32x4 v[8], wv[8]; float s = 0.f;
#pragma unroll
    for (int j = 0; j < 8; ++j) v[j] = xr[64 * j];
#pragma unroll
    for (int j = 0; j < 8; ++j) wv[j] = wr[64 * j];
#pragma unroll
    for (int j = 0; j < 8; ++j) s += (v[j].x * v[j].x + v[j].y * v[j].y) + (v[j].z * v[j].z + v[j].w * v[j].w);
    const float rstd = rsqrtf(wave_sum(s) * (1.f / DM) + EPS);
    u32x2* o8 = (u32x2*)orow + lane;
#pragma unroll
    for (int j = 0; j < 8; ++j) { const f32x4 ww = wv[j]; u32x2 o; o.x = pk2(v[j].x * rstd * ww.x, v[j].y * rstd * ww.y); o.y = pk2(v[j].z * rstd * ww.z, v[j].w * rstd * ww.w); o8[64 * j] = o; }
}
DI void rms_row_f32(const float* xrow, const float* w, float* orow, int lane) {
    const f32x4* xr = (const f32x4*)xrow + lane; const f32x4* wr = (const f32x4*)w + lane;
    f32x4 v[8]; float s = 0.f;
#pragma unroll
    for (int j = 0; j < 8; ++j) { v[j] = xr[64 * j]; s += (v[j].x * v[j].x + v[j].y * v[j].y) + (v[j].z * v[j].z + v[j].w * v[j].w); }
    const float rstd = rsqrtf(wave_sum(s) * (1.f / DM) + EPS);
    f32x4* o = (f32x4*)orow + lane;
#pragma unroll
    for (int j = 0; j < 8; ++j) { const f32x4 ww = wr[64 * j]; o[64 * j] = v[j] * rstd * ww; }
}
DI void rms_rows2_bf16(const float* x0, const float* x1, const float* w, bf16* o0, bf16* o1, int lane) {
    const f32x4* xr0 = (const f32x4*)x0 + lane; const f32x4* xr1 = (const f32x4*)x1 + lane; const f32x4* wr = (const f32x4*)w + lane;
    f32x4 v0[8], v1[8], wv[8]; float s0 = 0.f, s1 = 0.f;
#pragma unroll
    for (int j = 0; j < 8; ++j) { v0[j] = xr0[64 * j]; v1[j] = xr1[64 * j]; }
#pragma unroll
    for (int j = 0; j < 8; ++j) wv[j] = wr[64 * j];
#pragma unroll
    for (int j = 0; j < 8; ++j) { s0 += (v0[j].x * v0[j].x + v0[j].y * v0[j].y) + (v0[j].z * v0[j].z + v0[j].w * v0[j].w); s1 += (v1[j].x * v1[j].x + v1[j].y * v1[j].y) + (v1[j].z * v1[j].z + v1[j].w * v1[j].w); }
    const float r0 = rsqrtf(wave_sum(s0) * (1.f / DM) + EPS), r1 = rsqrtf(wave_sum(s1) * (1.f / DM) + EPS);
    u32x2* p0 = (u32x2*)o0 + lane; u32x2* p1 = (u32x2*)o1 + lane;
#pragma unroll
    for (int j = 0; j < 8; ++j) { const f32x4 ww = wv[j]; u32x2 a, b;
        a.x = pk2(v0[j].x * r0 * ww.x, v0[j].y * r0 * ww.y); a.y = pk2(v0[j].z * r0 * ww.z, v0[j].w * r0 * ww.w);
        b.x = pk2(v1[j].x * r1 * ww.x, v1[j].y * r1 * ww.y); b.y = pk2(v1[j].z * r1 * ww.z, v1[j].w * r1 * ww.w);
        p0[64 * j] = a; p1[64 * j] = b; }
}
DI void rms_rows2_f32(const float* x0, const float* x1, const float* w, float* o0, float* o1, int lane) {
    const f32x4* xr0 = (const f32x4*)x0 + lane; const f32x4* xr1 = (const f32x4*)x1 + lane; const f32x4* wr = (const f32x4*)w + lane;
    f32x4 v0[8], v1[8], wv[8]; float s0 = 0.f, s1 = 0.f;
#pragma unroll
    for (int j = 0; j < 8; ++j) { v0[j] = xr0[64 * j]; v1[j] = xr1[64 * j]; }
#pragma unroll
    for (int j = 0; j < 8; ++j) wv[j] = wr[64 * j];
#pragma unroll
    for (int j = 0; j < 8; ++j) { s0 += (v0[j].x * v0[j].x + v0[j].y * v0[j].y) + (v0[j].z * v0[j].z + v0[j].w * v0[j].w); s1 += (v1[j].x * v1[j].x + v1[j].y * v1[j].y) + (v1[j].z * v1[j].z + v1[j].w * v1[j].w); }
    const float r0 = rsqrtf(wave_sum(s0) * (1.f / DM) + EPS), r1 = rsqrtf(wave_sum(s1) * (1.f / DM) + EPS);
    f32x4* p0 = (f32x4*)o0 + lane; f32x4* p1 = (f32x4*)o1 + lane;
#pragma unroll
    for (int j = 0; j < 8; ++j) { p0[64 * j] = v0[j] * r0 * wv[j]; p1[64 * j] = v1[j] * r1 * wv[j]; }
}
DI void rms_rows2_b2b(const bf16* x0, const bf16* x1, const float* w, bf16* o0, bf16* o1, int lane) {
    const u32x4* xr0 = (const u32x4*)x0 + lane; const u32x4* xr1 = (const u32x4*)x1 + lane;
    u32x4 v0[4], v1[4]; f32x4 wv[4][2]; float s0 = 0.f, s1 = 0.f;
#pragma unroll
    for (int j = 0; j < 4; ++j) { v0[j] = xr0[64 * j]; v1[j] = xr1[64 * j]; }
#pragma unroll
    for (int j = 0; j < 4; ++j) { const float* wp = w + 8 * lane + 512 * j; wv[j][0] = *(const f32x4*)wp; wv[j][1] = *(const f32x4*)(wp + 4); }
    float a0[4][8], a1[4][8];
#pragma unroll
    for (int j = 0; j < 4; ++j) {
        const unsigned p0[4] = {v0[j].x, v0[j].y, v0[j].z, v0[j].w}, p1[4] = {v1[j].x, v1[j].y, v1[j].z, v1[j].w};
#pragma unroll
        for (int e = 0; e < 4; ++e) { a0[j][2 * e] = bflo(p0[e]); a0[j][2 * e + 1] = bfhi(p0[e]); a1[j][2 * e] = bflo(p1[e]); a1[j][2 * e + 1] = bfhi(p1[e]); }
#pragma unroll
        for (int e = 0; e < 8; ++e) { s0 += a0[j][e] * a0[j][e]; s1 += a1[j][e] * a1[j][e]; } }
    const float r0 = rsqrtf(wave_sum(s0) * (1.f / DM) + EPS), r1 = rsqrtf(wave_sum(s1) * (1.f / DM) + EPS);
    u32x4* q0 = (u32x4*)o0 + lane; u32x4* q1 = (u32x4*)o1 + lane;
#pragma unroll
    for (int j = 0; j < 4; ++j) { const float ww[8] = {wv[j][0].x, wv[j][0].y, wv[j][0].z, wv[j][0].w, wv[j][1].x, wv[j][1].y, wv[j][1].z, wv[j][1].w};
        u32x4 oa, ob;
        oa.x = pk2(a0[j][0] * r0 * ww[0], a0[j][1] * r0 * ww[1]); oa.y = pk2(a0[j][2] * r0 * ww[2], a0[j][3] * r0 * ww[3]); oa.z = pk2(a0[j][4] * r0 * ww[4], a0[j][5] * r0 * ww[5]); oa.w = pk2(a0[j][6] * r0 * ww[6], a0[j][7] * r0 * ww[7]);
        ob.x = pk2(a1[j][0] * r1 * ww[0], a1[j][1] * r1 * ww[1]); ob.y = pk2(a1[j][2] * r1 * ww[2], a1[j][3] * r1 * ww[3]); ob.z = pk2(a1[j][4] * r1 * ww[4], a1[j][5] * r1 * ww[5]); ob.w = pk2(a1[j][6] * r1 * ww[6], a1[j][7] * r1 * ww[7]);
        q0[64 * j] = oa; q1[64 * j] = ob; }
}
DI void rms_rows2_b2f(const bf16* x0, const bf16* x1, const float* w, float* o0, float* o1, int lane) {
    const u32x4* xr0 = (const u32x4*)x0 + lane; const u32x4* xr1 = (const u32x4*)x1 + lane;
    u32x4 v0[4], v1[4]; f32x4 wv[4][2]; float s0 = 0.f, s1 = 0.f;
#pragma unroll
    for (int j = 0; j < 4; ++j) { v0[j] = xr0[64 * j]; v1[j] = xr1[64 * j]; }
#pragma unroll
    for (int j = 0; j < 4; ++j) { const float* wp = w + 8 * lane + 512 * j; wv[j][0] = *(const f32x4*)wp; wv[j][1] = *(const f32x4*)(wp + 4); }
    float a0[4][8], a1[4][8];
#pragma unroll
    for (int j = 0; j < 4; ++j) {
        const unsigned p0[4] = {v0[j].x, v0[j].y, v0[j].z, v0[j].w}, p1[4] = {v1[j].x, v1[j].y, v1[j].z, v1[j].w};
#pragma unroll
        for (int e = 0; e < 4; ++e) { a0[j][2 * e] = bflo(p0[e]); a0[j][2 * e + 1] = bfhi(p0[e]); a1[j][2 * e] = bflo(p1[e]); a1[j][2 * e + 1] = bfhi(p1[e]); }
#pragma unroll
        for (int e = 0; e < 8; ++e) { s0 += a0[j][e] * a0[j][e]; s1 += a1[j][e] * a1[j][e]; } }
    const float r0 = rsqrtf(wave_sum(s0) * (1.f / DM) + EPS), r1 = rsqrtf(wave_sum(s1) * (1.f / DM) + EPS);
#pragma unroll
    for (int j = 0; j < 4; ++j) { float* q0 = o0 + 8 * lane + 512 * j; float* q1 = o1 + 8 * lane + 512 * j;
        *(f32x4*)q0 = (f32x4){a0[j][0], a0[j][1], a0[j][2], a0[j][3]} * r0 * wv[j][0]; *(f32x4*)(q0 + 4) = (f32x4){a0[j][4], a0[j][5], a0[j][6], a0[j][7]} * r0 * wv[j][1];
        *(f32x4*)q1 = (f32x4){a1[j][0], a1[j][1], a1[j][2], a1[j][3]} * r1 * wv[j][0]; *(f32x4*)(q1 + 4) = (f32x4){a1[j][4], a1[j][5], a1[j][6], a1[j][7]} * r1 * wv[j][1]; }
}
DI void p0_prep(const Args& a, unsigned char* lds, int tid, int G) {
    const int lane = tid & 63, wave = tid >> 6, gw = blockIdx.x * 8 + wave, NGW = G * 8;
    float* scr = (float*)(lds + wave * 16384);
    unsigned char* ws = a.ws;
    bf16* win = (bf16*)(ws + WS_WIN); bf16* wout = (bf16*)(ws + WS_WOUT); bf16* wgu = (bf16*)(ws + WS_WGU); bf16* wdn = (bf16*)(ws + WS_WDN); bf16* nb = (bf16*)(ws + WS_NBUF);
    constexpr int I_IN = 32 * 225, I_OUT = 32 * 64, I_G = 32 * 176, I_D = 88 * 64, NITEMS = I_IN + I_OUT + 2 * I_G + I_D;
    for (int it = gw; it < NITEMS; it += 2 * NGW) {
        float tv0[32], tv1[32];
        const float* W0; bf16* T0; int K0, N0, m0, i0; const float* W1; bf16* T1; int K1, N1, m1, i1;
        const bool has1 = it + NGW < NITEMS;
        p0_item(a, it, W0, T0, K0, N0, m0, i0); p0_item(a, has1 ? it + NGW : it, W1, T1, K1, N1, m1, i1);
        transpose_load(W0, N0, i0, lane, tv0);
        if (has1) transpose_load(W1, N1, i1, lane, tv1);
        transpose_store(tv0, K0, N0, T0, m0, scr, i0, lane, a.in[12]);
        if (has1) transpose_store(tv1, K1, N1, T1, m1, scr, i1, lane, a.in[12]);
    }
    { const int gt = blockIdx.x * 512 + tid, GT = G * 512; const u32x4 z = {0u, 0u, 0u, 0u};
      u32x4* zw = (u32x4*)(win + (size_t)7200 * DM); for (int i = gt; i < 224 * 256; i += GT) zw[i] = z;
      u32x4* zn = (u32x4*)(nb + (size_t)(META0 + NB * NMETA) * DM); for (int i = gt; i < 192 * 256; i += GT) zn[i] = z; }
    for (int m = 2 * gw; m < MX + NB * NMETA; m += 2 * NGW) {
        const float* s0 = m < MX ? a.in[0] + (size_t)m * DM : a.in[1] + (size_t)((m - MX) & 15) * DM;
        const float* s1 = m < MX ? s0 + DM : a.in[1] + (size_t)((m + 1 - MX) & 15) * DM;
        rms_rows2_bf16(s0, s1, a.in[2], nb + (size_t)m * DM, nb + (size_t)(m + 1) * DM, lane);
    }
}

DI void p1_tail(const Args& a, unsigned char* lds, int tid, int bx, int G) {
    const int lane = tid & 63, wave = tid >> 6, r = lane & 31, hh = lane >> 5;
    const bf16* nbuf = (const bf16*)(a.ws + WS_NBUF); const bf16* win = (const bf16*)(a.ws + WS_WIN);
    bf16* proj = (bf16*)(a.ws + WS_PROJ); float* small = (float*)(a.ws + WS_SMALL);
    float* red = (float*)lds;
    for (int u = bx; u < 256; u += G) {
        f32x16 acc[4];
#pragma unroll
        for (int mt = 0; mt < 4; ++mt) for (int i = 0; i < 16; ++i) acc[mt][i] = 0.f;
        const bf16* bp = win + (size_t)(7168 + r) * DM + 256 * wave + 8 * hh; const bf16* ap = nbuf + (size_t)(128 * u + r) * DM + 256 * wave + 8 * hh;
#pragma unroll 4
        for (int s_ = 0; s_ < 16; ++s_) { const bf16x8 bf = *(const bf16x8*)(bp + 16 * s_);
#pragma unroll
            for (int mt = 0; mt < 4; ++mt) { const bf16x8 af = *(const bf16x8*)(ap + (size_t)(32 * mt) * DM + 16 * s_); acc[mt] = MFMA32(af, bf, acc[mt]); } }
#pragma unroll
        for (int mt = 0; mt < 4; ++mt)
#pragma unroll
            for (int i = 0; i < 16; ++i) red[wave * 4096 + (mt * 16 + i) * 64 + lane] = acc[mt][i];
        __syncthreads();
#pragma unroll
        for (int j = 0; j < 8; ++j) { const int o = tid + 512 * j; float sum = 0.f;
#pragma unroll
            for (int w = 0; w < 8; ++w) sum += red[w * 4096 + o];
            const int lo = o & 63, i = (o >> 6) & 15, mt = o >> 10; small[(size_t)(128 * u + 32 * mt + crow(i, lo >> 5)) * 32 + (lo & 31)] = sum; }
        __syncthreads();
    }
    for (int g = bx; g < 225; g += G) {
        f32x16 acc; for (int i = 0; i < 16; ++i) acc[i] = 0.f;
        const bf16* bp = win + (size_t)(32 * g + r) * DM + 256 * wave + 8 * hh; const bf16* ap = nbuf + (size_t)(META0 + (r & 15)) * DM + 256 * wave + 8 * hh;
#pragma unroll 4
        for (int s_ = 0; s_ < 16; ++s_) { const bf16x8 bf = *(const bf16x8*)(bp + 16 * s_); const bf16x8 af = *(const bf16x8*)(ap + 16 * s_); acc = MFMA32(af, bf, acc); }
#pragma unroll
        for (int i = 0; i < 16; ++i) red[wave * 1024 + i * 64 + lane] = acc[i];
        __syncthreads();
#pragma unroll
        for (int j = 0; j < 2; ++j) { const int o = tid + 512 * j; float sum = 0.f;
#pragma unroll
            for (int w = 0; w < 8; ++w) sum += red[w * 1024 + o];
            const int lo = o & 63, i = o >> 6, row16 = crow(i, lo >> 5), c = lo & 31;
            if (row16 < 16) {
#pragma unroll
                for (int b = 0; b < NB; ++b) { const size_t row = (size_t)(META0 + NMETA * b + row16);
                    if (g < 224) proj[row * PROJ_LD + 32 * g + c] = f2bf(sum); else small[row * 32 + c] = sum; } } }
        __syncthreads();
    }
}

#define SB() __builtin_amdgcn_sched_barrier(0)
#define LBAR_NOBAR() asm volatile("s_waitcnt lgkmcnt(0)" ::: "memory")
#define LBAR() do { asm volatile("s_waitcnt lgkmcnt(0)" ::: "memory"); __builtin_amdgcn_s_barrier(); asm volatile("" ::: "memory"); } while (0)
DI void gdn_stage_raw(const Args& a, unsigned char* lds, int item, int t, int nt) {
    const int h = item & 7, bc = item >> 3, c = bc % NCH, b = bc / NCH, p0 = c * 64 - 48;
    bf16* RAW = (bf16*)lds; const bf16* proj = (const bf16*)(a.ws + WS_PROJ);
    const int nit = (67 * 48 + nt - 1) / nt;
    for (int k0 = 0; k0 < nit; k0 += 7) {
        u32x4 v[7];
#pragma unroll
        for (int k = 0; k < 7; ++k) { const int idx = min(t + (k0 + k) * nt, 67 * 48 - 1); const int rr = idx / 48, ch = idx % 48, mat = ch >> 4, cc = ch & 15, p = p0 + rr - 3;
            v[k] = *(const u32x4*)(proj + (size_t)row_of(b, max(p, 0)) * PROJ_LD + mat * 1024 + h * 128 + cc * 8); if (p < 0) v[k] = (u32x4){0u, 0u, 0u, 0u}; }
#pragma unroll
        for (int k = 0; k < 7; ++k) { const int idx = t + (k0 + k) * nt; if (k0 + k < nit && idx < 67 * 48) { const int rr = idx / 48, ch = idx % 48; *(u32x4*)(RAW + rr * 392 + (ch >> 4) * 128 + (ch & 15) * 8) = v[k]; } }
    }
}
DI void gdn_gates(const Args& a, float* GCb, int item, int lane) {
    const int h = item & 7, bc = item >> 3, c = bc % NCH, b = bc / NCH, p = c * 64 - 48 + lane;
    const float* small = (const float*)(a.ws + WS_SMALL);
    float beta = 0.f, g = 0.f;
    { const float* sr = small + (size_t)row_of(b, max(p, 0)) * 32; const float av = sr[h], bv = sr[8 + h];
        beta = sigmoid_f(bv); const float xs = av + a.in[6][h]; const float sp = fmaxf(xs, 0.f) + log1pf(__expf(-fabsf(xs)));
        g = -__expf(a.in[5][h]) * sp; if (p < 0) { beta = 0.f; g = 0.f; } }
#pragma unroll
    for (int off = 1; off < 64; off <<= 1) { const float t = __shfl_up(g, off); if (lane >= off) g += t; }
    GCb[lane] = g; GCb[64 + lane] = beta;
}
DI void p2_gdn_item(const Args& a, unsigned char* lds, int item, int next, int par, int tid) {
    const int h = item & 7, bc = item >> 3, c = bc % NCH, b = bc / NCH;
    const int lane = tid & 63, wv = tid >> 6;
    bf16* RAW = (bf16*)lds;
    bf16* QB = (bf16*)(lds + 53248);
    bf16* KB = (bf16*)(lds + 53248 + 17408);
    float* AMD = (float*)(lds + 88064);
    bf16* RHS = (bf16*)(lds + 106496);
    float* GC = (float*)(lds + 140288) + 128 * par;
    float* BETA = GC + 64;
    unsigned char* it = a.ws + WS_GDN + (size_t)item * GDN_ITEM;
    bf16* o_w = (bf16*)it; bf16* o_qd = (bf16*)(it + 17408); bf16* o_kdT = (bf16*)(it + 34816); bf16* o_qk = (bf16*)(it + 53248); bf16* o_uT = (bf16*)(it + 62464);
    const int p0 = c * 64 - 48;
#ifndef REPS1
#define REPS1 1
#define REPS2 1
#define REPS3 1
#endif
    for (int rep_ = 0; rep_ < REPS1; ++rep_) {
        const int cgi = tid & 15, tq = tid >> 4, t0 = 2 * tq;
        const float* cw = (const float*)(lds + 141312);
#pragma unroll
        for (int mat = 0; mat < 3; ++mat) {
            f32x4 w4[4][2];
#pragma unroll
            for (int i = 0; i < 4; ++i) { const float* wp = cw + i * 384 + mat * 128 + cgi * 8; w4[i][0] = *(const f32x4*)wp; w4[i][1] = *(const f32x4*)(wp + 4); }
            float y[2][8];
#pragma unroll
            for (int tt = 0; tt < 2; ++tt)
#pragma unroll
                for (int e = 0; e < 8; ++e) y[tt][e] = 0.f;
#pragma unroll
            for (int rr = 0; rr < 5; ++rr) {
                const u32x4 rv = *(const u32x4*)(RAW + (t0 + rr) * 392 + mat * 128 + cgi * 8);
                float x[8] = {bflo(rv.x), bfhi(rv.x), bflo(rv.y), bfhi(rv.y), bflo(rv.z), bfhi(rv.z), bflo(rv.w), bfhi(rv.w)};
#pragma unroll
                for (int tt = 0; tt < 2; ++tt) { const int i = rr - tt; if (i >= 0 && i < 4) {
#pragma unroll
                    for (int e = 0; e < 8; ++e) y[tt][e] += w4[i][e >> 2][e & 3] * x[e]; } }
            }
#pragma unroll
            for (int tt = 0; tt < 2; ++tt) {
                const int t = t0 + tt; const bool valid = (p0 + t) >= 0;
                float s[8]; float ss = 0.f;
#pragma unroll
                for (int e = 0; e < 8; ++e) { s[e] = valid ? silu_f(y[tt][e]) : 0.f; ss += s[e] * s[e]; }
                const float gct = GC[t], eg = __expf(gct), bt = BETA[t];
                if (mat < 2) {
                    ss += __shfl_xor(ss, 1); ss += __shfl_xor(ss, 2); ss += __shfl_xor(ss, 4); ss += __shfl_xor(ss, 8);
                    const float rn = rsqrtf(ss + EPS) * (mat == 0 ? 0.08838834764831845f : 1.0f);
#pragma unroll
                    for (int e = 0; e < 8; ++e) s[e] *= rn;
                }
                u32x4 o; o.x = pk2(s[0], s[1]); o.y = pk2(s[2], s[3]); o.z = pk2(s[4], s[5]); o.w = pk2(s[6], s[7]);
                if (mat == 0) {
                    *(u32x4*)(QB + t * 136 + cgi * 8) = o;
                    u32x2 lo, hi; lo.x = pk2(s[0] * eg, s[1] * eg); lo.y = pk2(s[2] * eg, s[3] * eg); hi.x = pk2(s[4] * eg, s[5] * eg); hi.y = pk2(s[6] * eg, s[7] * eg);
                    int qoff = t * 136 + 16 * (cgi >> 1) + 4 * (cgi & 1); asm volatile("" : "+v"(qoff));
                    bf16* dst = o_qd + qoff;
                    *(u32x2*)dst = lo; *(u32x2*)(dst + 8) = hi;
                } else if (mat == 1) {
                    *(u32x4*)(KB + t * 136 + cgi * 8) = o;
                    const float f = bt * eg; u32x4 o2; o2.x = pk2(s[0] * f, s[1] * f); o2.y = pk2(s[2] * f, s[3] * f); o2.z = pk2(s[4] * f, s[5] * f); o2.w = pk2(s[6] * f, s[7] * f);
                    *(u32x4*)(RHS + t * 264 + 128 + cgi * 8) = o2;
                } else {
                    u32x4 o2; o2.x = pk2(s[0] * bt, s[1] * bt); o2.y = pk2(s[2] * bt, s[3] * bt); o2.z = pk2(s[4] * bt, s[5] * bt); o2.w = pk2(s[6] * bt, s[7] * bt);
                    *(u32x4*)(RHS + t * 264 + cgi * 8) = o2;
                }
            }
        }
    LBAR(); }
    for (int rep_ = 0; rep_ < REPS2; ++rep_) {
        const int which = wv >> 2, ti = (wv >> 1) & 1, tj = wv & 1, r = lane & 31, hh = lane >> 5;
        if (ti == 0 && tj == 1) {
            if (which == 0) {
                const int J = 32 + r;
#pragma unroll
                for (int i = 0; i < 16; ++i) AMD[(J & 1) * 2300 + crow(i, hh) * 36 + (J >> 1)] = 0.f;
            }
        } else {
            const bf16* Ab = (which ? QB : KB) + (32 * ti + r) * 136 + 8 * hh; const bf16* Bb = KB + (32 * tj + r) * 136 + 8 * hh;
            f32x16 acc; for (int i = 0; i < 16; ++i) acc[i] = 0.f;
#pragma unroll
            for (int ks = 0; ks < 8; ++ks) { const bf16x8 av = *(const bf16x8*)(Ab + 16 * ks); const bf16x8 bv = *(const bf16x8*)(Bb + 16 * ks); acc = MFMA32(av, bv, acc); }
            const int J = 32 * tj + r; const float gj = GC[J];
            int koff = (J & ~15) + perm16(J & 15); asm volatile("" : "+v"(koff));
#pragma unroll
            for (int i = 0; i < 16; ++i) {
                const int I = 32 * ti + crow(i, hh); const float gi = GC[I];
                if (which == 0) AMD[(J & 1) * 2300 + I * 36 + (J >> 1)] = (J < I) ? BETA[I] * acc[i] * __expf(gi - gj) : 0.f;
                else o_qk[I * 72 + koff] = f2bf((J <= I) ? acc[i] * __expf(gi - gj) : 0.f);
            }
        }
    LBAR(); }
    {
        const float gcl = GC[63];
        u32x4 nx[7]; int nh = 0, nb = 0, np0 = 0;
        if (next >= 0) { nh = next & 7; const int nbc = next >> 3; np0 = (nbc % NCH) * 64 - 48; nb = nbc / NCH;
#pragma unroll
            for (int k = 0; k < 7; ++k) { const int idx = min(tid + 512 * k, 67 * 48 - 1); const int rr = idx / 48, ch = idx % 48, mat = ch >> 4, cc = ch & 15, p = np0 + rr - 3;
                nx[k] = *(const u32x4*)((const bf16*)(a.ws + WS_PROJ) + (size_t)row_of(nb, max(p, 0)) * PROJ_LD + mat * 1024 + nh * 128 + cc * 8); if (p < 0) nx[k] = (u32x4){0u, 0u, 0u, 0u}; } }
#pragma unroll
        for (int q = 0; q < 2; ++q) {
            const int idx = tid + 512 * q, dk = idx & 127, oct = idx >> 7, G16 = oct >> 1, f = oct & 1;
            float v[8];
#pragma unroll
            for (int jj = 0; jj < 8; ++jj) { const int t = 16 * G16 + 8 * (jj >> 2) + 4 * f + (jj & 3); v[jj] = bf2f(KB[t * 136 + dk]) * __expf(gcl - GC[t]); }
            u32x4 o; o.x = pk2(v[0], v[1]); o.y = pk2(v[2], v[3]); o.z = pk2(v[4], v[5]); o.w = pk2(v[6], v[7]);
            *(u32x4*)(o_kdT + dk * 72 + 8 * oct) = o;
        }
        if (next >= 0) {
#pragma unroll
            for (int k = 0; k < 7; ++k) { const int idx = tid + 512 * k; if (idx < 67 * 48) { const int rr = idx / 48, ch = idx % 48; *(u32x4*)(RAW + rr * 392 + (ch >> 4) * 128 + (ch & 15) * 8) = nx[k]; } }
        }
        if (next >= 0 && wv == 7) gdn_gates(a, (float*)(lds + 140288) + 128 * (par ^ 1), next, lane);
        if (wv < 4) {
            const int cp = tid >> 1, hf = tid & 1;
            int zoff; asm volatile("v_mov_b32 %0, 0" : "=v"(zoff));
            const float* AMh = AMD + hf * 2300 + zoff;
            f32x2_t xh[32];
#pragma unroll
            for (int q = 0; q < 32; ++q) xh[q] = (f32x2_t){0.f, 0.f};
            { const unsigned r0 = *(const unsigned*)(RHS + 2 * cp); if (hf == 0) xh[0] = (f32x2_t){bflo(r0), bfhi(r0)}; }
#pragma unroll
            for (int ii = 0; ii < 31; ++ii) {
                const int i = 2 * ii + 1, j = i + 1;
                f32x4 Ai[8], Aj[8];
#pragma unroll
                for (int r4 = 0; r4 < (ii + 4) / 4; ++r4) { Ai[r4] = *(const f32x4*)(AMh + i * 36 + 4 * r4); Aj[r4] = *(const f32x4*)(AMh + j * 36 + 4 * r4); }
                const unsigned ri = *(const unsigned*)(RHS + i * 264 + 2 * cp), rj = *(const unsigned*)(RHS + j * 264 + 2 * cp);
                const float aji = AMD[2300 + j * 36 + ii + zoff];
                f32x2_t ai[2] = {{0.f, 0.f}, {0.f, 0.f}}, aj[2] = {{0.f, 0.f}, {0.f, 0.f}};
#pragma unroll
                for (int q = 0; q < ii + 1; ++q) { const float vi = Ai[q >> 2][q & 3], vj = Aj[q >> 2][q & 3]; ai[q & 1] += (f32x2_t){vi, vi} * xh[q]; aj[q & 1] += (f32x2_t){vj, vj} * xh[q]; }
                f32x2_t ti = ai[0] + ai[1], tj = aj[0] + aj[1];
                ti.x += xor1(ti.x); ti.y += xor1(ti.y); tj.x += xor1(tj.x); tj.y += xor1(tj.y);
                const f32x2_t xi = (f32x2_t){bflo(ri), bfhi(ri)} - ti;
                const f32x2_t xj = (f32x2_t){bflo(rj), bfhi(rj)} - tj - (f32x2_t){aji, aji} * xi;
                if (hf == 1) xh[ii] = xi; else xh[ii + 1] = xj;
            }
            {
                f32x4 Ac[8];
#pragma unroll
                for (int r4 = 0; r4 < 8; ++r4) Ac[r4] = *(const f32x4*)(AMh + 63 * 36 + 4 * r4);
                const unsigned rr = *(const unsigned*)(RHS + 63 * 264 + 2 * cp);
                f32x2_t acc[2] = {{0.f, 0.f}, {0.f, 0.f}};
#pragma unroll
                for (int q = 0; q < 32; ++q) { const float av = Ac[q >> 2][q & 3]; acc[q & 1] += (f32x2_t){av, av} * xh[q]; }
                f32x2_t tot = acc[0] + acc[1];
                tot.x += xor1(tot.x); tot.y += xor1(tot.y);
                const f32x2_t xi = (f32x2_t){bflo(rr), bfhi(rr)} - tot;
                if (hf == 1) xh[31] = xi;
            }
            f32x2_t ev[16], od[16];
#pragma unroll
            for (int q = 0; q < 16; ++q) { const f32x2_t send = hf ? xh[q] : xh[16 + q]; f32x2_t got; got.x = xor1(send.x); got.y = xor1(send.y); ev[q] = hf ? got : xh[q]; od[q] = hf ? xh[16 + q] : got; }
            if (wv < 2) {
                bf16* dst = o_uT + (2 * cp) * 72 + 32 * hf;
#pragma unroll
                for (int c4 = 0; c4 < 4; ++c4) { u32x4 o0, o1;
                    o0.x = pk2(ev[4 * c4].x, od[4 * c4].x); o0.y = pk2(ev[4 * c4 + 1].x, od[4 * c4 + 1].x); o0.z = pk2(ev[4 * c4 + 2].x, od[4 * c4 + 2].x); o0.w = pk2(ev[4 * c4 + 3].x, od[4 * c4 + 3].x);
                    o1.x = pk2(ev[4 * c4].y, od[4 * c4].y); o1.y = pk2(ev[4 * c4 + 1].y, od[4 * c4 + 1].y); o1.z = pk2(ev[4 * c4 + 2].y, od[4 * c4 + 2].y); o1.w = pk2(ev[4 * c4 + 3].y, od[4 * c4 + 3].y);
                    *(u32x4*)(dst + 8 * c4) = o0; *(u32x4*)(dst + 72 + 8 * c4) = o1; }
            } else {
                const int dk = 2 * cp - 128; unsigned* dst = (unsigned*)(QB + (dk & ~15) + perm16(dk & 15) + 32 * hf * 136);
#pragma unroll
                for (int q = 0; q < 16; ++q) { dst[(2 * q) * 68] = pk2(ev[q].x, ev[q].y); dst[(2 * q + 1) * 68] = pk2(od[q].x, od[q].y); }
            }
        }
        if (tid == 0) *(float*)((unsigned char*)QB + 256) = __expf(gcl);
        LBAR();
#pragma unroll
        for (int k = 0; k < 3; ++k) { const int idx = tid + 512 * k; if (idx < 1088) *(u32x4*)(it + 16 * idx) = *(const u32x4*)((const unsigned char*)QB + 16 * idx); }
        LBAR();
    }
}
DI void p2_gla_item(const Args& a, unsigned char* lds, int item, int tid) {
    const int h = item & 3, bc = item >> 2, c = bc % NCH, b = bc / NCH;
    const int lane = tid & 63, wv = tid >> 6;
    float* LR = (float*)lds;
    bf16* QB = (bf16*)(lds + 4096);
    bf16* KB = (bf16*)(lds + 4096 + 17408);
    bf16* VB = (bf16*)(lds + 4096 + 2 * 17408);
    float* PS = (float*)(lds + 4096 + 2 * 17408 + 33792);
    const bf16* proj = (const bf16*)(a.ws + WS_PROJ); const float* small = (const float*)(a.ws + WS_SMALL);
    unsigned char* it = (unsigned char*)a.out + (size_t)item * GLA_ITEM;
    bf16* o_qt = (bf16*)it; bf16* o_kdT = (bf16*)(it + 17408); bf16* o_sc = (bf16*)(it + 35840); float* o_dec = (float*)(it + 45056); bf16* o_vT = (bf16*)(it + 45568);
    const int p0 = c * 64 - 48;
    bf16 qraw[16], kraw[16];
    { const int d = tid & 127, tq = tid >> 7;
#pragma unroll
      for (int tt = 0; tt < 16; ++tt) { const int p = p0 + 16 * tq + tt; const bf16* rp = proj + (size_t)row_of(b, max(p, 0)) * PROJ_LD + h * 128 + d;
          qraw[tt] = rp[4096]; kraw[tt] = rp[4608]; if (p < 0) { qraw[tt] = 0; kraw[tt] = 0; } } }
    { float lrv[2]; u32x4 vv[4];
#pragma unroll
      for (int k = 0; k < 2; ++k) { const int idx = tid + 512 * k, t = idx >> 4, r = idx & 15, p = p0 + t; lrv[k] = small[(size_t)row_of(b, max(p, 0)) * 32 + 16 + r]; if (p < 0) lrv[k] = 0.f; }
#pragma unroll
      for (int k = 0; k < 4; ++k) { const int idx = tid + 512 * k, t = idx >> 5, cc = idx & 31, p = p0 + t; vv[k] = *(const u32x4*)(proj + (size_t)row_of(b, max(p, 0)) * PROJ_LD + 5120 + h * 256 + cc * 8); if (p < 0) vv[k] = (u32x4){0u, 0u, 0u, 0u}; }
#pragma unroll
      for (int k = 0; k < 2; ++k) LR[tid + 512 * k] = lrv[k];
#pragma unroll
      for (int k = 0; k < 4; ++k) { const int idx = tid + 512 * k; *(u32x4*)(VB + (idx >> 5) * 264 + (idx & 31) * 8) = vv[k]; } }
    LBAR();
    {
        const int d = tid & 127, tq = tid >> 7;
        float w2r[16];
#pragma unroll
        for (int r = 0; r < 16; ++r) w2r[r] = a.in[8][r * 512 + h * 128 + d];
        const float bias = a.in[9][h * 128 + d];
        float cs[16]; float run = 0.f;
#pragma unroll
        for (int tt = 0; tt < 16; ++tt) {
            const int t = 16 * tq + tt; float z = bias;
#pragma unroll
            for (int r4 = 0; r4 < 4; ++r4) { const f32x4 l4 = *(const f32x4*)(LR + t * 16 + 4 * r4); z += l4.x * w2r[4 * r4] + l4.y * w2r[4 * r4 + 1] + l4.z * w2r[4 * r4 + 2] + l4.w * w2r[4 * r4 + 3]; }
            const float ls = fminf(z, 0.f) - __logf(1.0f + __expf(-fabsf(z)));
            run += ((p0 + t) >= 0) ? ls * (1.f / 16.f) : 0.f; cs[tt] = run;
        }
        PS[tq * 128 + d] = run;
        LBAR();
        float off = 0.f, total = 0.f;
#pragma unroll
        for (int q = 0; q < 4; ++q) { const float v = PS[q * 128 + d]; total += v; if (q < tq) off += v; }
        float kd[16];
#pragma unroll
        for (int tt = 0; tt < 16; ++tt) {
            const int t = 16 * tq + tt; const float bc_ = off + cs[tt];
            const float qv = bf2f(qraw[tt]) * 0.08838834764831845f, kv = bf2f(kraw[tt]);
            const float qt = qv * __expf(bc_), kt = kv * __expf(-bc_); kd[tt] = kv * __expf(total - bc_);
            const bf16 qtb = f2bf(qt);
            QB[t * 136 + d] = qtb; KB[t * 136 + d] = f2bf(kt);
            o_qt[t * 136 + (d & ~15) + perm16(d & 15)] = qtb;
        }
        { bf16* dst = o_kdT + d * 72 + 16 * tq; u32x4 o0, o1;
          o0.x = pk2(kd[0], kd[1]); o0.y = pk2(kd[2], kd[3]); o0.z = pk2(kd[4], kd[5]); o0.w = pk2(kd[6], kd[7]);
          o1.x = pk2(kd[8], kd[9]); o1.y = pk2(kd[10], kd[11]); o1.z = pk2(kd[12], kd[13]); o1.w = pk2(kd[14], kd[15]);
          *(u32x4*)dst = o0; *(u32x4*)(dst + 8) = o1; }
        if (tq == 0) o_dec[d] = __expf(total);
#pragma unroll
        for (int q = 0; q < 4; ++q) { const int idx = tid + 512 * q, dv = idx & 255, oct = idx >> 8; bf16 v[8];
#pragma unroll
            for (int jj = 0; jj < 8; ++jj) v[jj] = VB[(8 * oct + jj) * 264 + dv];
            u32x4 o; o.x = v[0] | ((unsigned)v[1] << 16); o.y = v[2] | ((unsigned)v[3] << 16); o.z = v[4] | ((unsigned)v[5] << 16); o.w = v[6] | ((unsigned)v[7] << 16);
            *(u32x4*)(o_vT + dv * 72 + 8 * oct) = o; }
    }
    LBAR();
    if (wv < 3) {
        const int ti = wv == 0 ? 0 : 1, tj = wv == 2 ? 1 : 0, r = lane & 31, hh = lane >> 5;
        const bf16* Ab = QB + (32 * ti + r) * 136 + 8 * hh; const bf16* Bb = KB + (32 * tj + r) * 136 + 8 * hh;
        f32x16 acc; for (int i = 0; i < 16; ++i) acc[i] = 0.f;
#pragma unroll
        for (int ks = 0; ks < 8; ++ks) { const bf16x8 av = *(const bf16x8*)(Ab + 16 * ks); const bf16x8 bv = *(const bf16x8*)(Bb + 16 * ks); acc = MFMA32(av, bv, acc); }
        const int J = 32 * tj + r;
#pragma unroll
        for (int i = 0; i < 16; ++i) { const int I = 32 * ti + crow(i, hh); o_sc[I * 72 + J] = f2bf((J <= I) ? acc[i] : 0.f); }
    }
    LBAR();
}

DI bf16x8 pack8(const f32x16& x, int s) {
    u32x4 p; p.x = pk2(x[8 * s], x[8 * s + 1]); p.y = pk2(x[8 * s + 2], x[8 * s + 3]); p.z = pk2(x[8 * s + 4], x[8 * s + 5]); p.w = pk2(x[8 * s + 6], x[8 * s + 7]);
    return __builtin_bit_cast(bf16x8, p);
}
#define P3_BAR() do { asm volatile("s_waitcnt lgkmcnt(0)" ::: "memory"); __builtin_amdgcn_s_barrier(); asm volatile("" ::: "memory"); } while (0)
template <bool GDN> DI void p3_scan(const Args& a, unsigned char* lds, int bh, int sl, int tid) {
    constexpr int NSH = GDN ? 3904 : 2848, NTOT = NSH + 288, NPER = (NTOT + 447) / 448, ITEM = GDN ? GDN_ITEM : GLA_ITEM, SLOFF = GDN ? 62464 : 45568, NH = GDN ? 8 : 4;
    const int wave = __builtin_amdgcn_readfirstlane(tid >> 6), lane = tid & 63;
    const int b = bh / NH, h = bh % NH;
    const unsigned char* item0 = (GDN ? a.ws + WS_GDN : (const unsigned char*)a.out) + (size_t)((b * NCH) * NH + h) * ITEM;
    if (wave != 0) {
        const int pt = tid - 64;
        u32x4 R0[NPER], R1[NPER], R2[NPER];
#define P3_ISSUE(R, c_) do { const unsigned char* src_ = item0 + (size_t)(c_) * NH * ITEM; _Pragma("unroll") for (int k = 0; k < NPER; ++k) { const int i = pt + 448 * k; \
            if (i < NTOT) R[k] = *(const u32x4*)(src_ + (i < NSH ? 16 * i : SLOFF + sl * 4608 + 16 * (i - NSH))); } } while (0)
#define P3_COMMIT(R, bi_) do { unsigned char* dst_ = lds + (bi_) * P3_BUF; _Pragma("unroll") for (int k = 0; k < NPER; ++k) { const int i = pt + 448 * k; if (i < NTOT) *(u32x4*)(dst_ + 16 * i) = R[k]; } } while (0)
        P3_ISSUE(R0, 0); P3_COMMIT(R0, 0); P3_ISSUE(R1, 1); P3_ISSUE(R2, 2);
        P3_BAR();
        static_assert(NCH % 3 == 0, "producer loop is unrolled by the three register sets");
        for (int c = 0; c < NCH; c += 3) {
            if (c + 3 < NCH) P3_ISSUE(R0, c + 3);
            P3_COMMIT(R1, (c + 1) & 1);
            P3_BAR();
            if (c + 4 < NCH) P3_ISSUE(R1, c + 4);
            P3_COMMIT(R2, (c + 2) & 1);
            P3_BAR();
            if (c + 5 < NCH) P3_ISSUE(R2, c + 5);
            if (c + 3 < NCH) P3_COMMIT(R0, (c + 3) & 1);
            P3_BAR();
        }
#undef P3_ISSUE
#undef P3_COMMIT
        return;
    }
    const int r = lane & 31, hh = lane >> 5;
    __builtin_amdgcn_s_setprio(3);
    bf16* O = (bf16*)(a.ws + WS_NBUF) + (GDN ? h * 128 : 1024 + h * 256) + 32 * sl + r;
    f32x16 S[4];
#pragma unroll
    for (int m = 0; m < 4; ++m) for (int i = 0; i < 16; ++i) S[m][i] = 0.f;
    P3_BAR();
    for (int c = 0; c < NCH; ++c) {
        const unsigned char* base = lds + (c & 1) * P3_BUF;
        bf16x8 Sp[4][2];
#pragma unroll
        for (int m = 0; m < 4; ++m) { Sp[m][0] = pack8(S[m], 0); Sp[m][1] = pack8(S[m], 1); }
        f32x16 QS[2];
        bf16x8 Vp[2][2];
        const unsigned char* qp = base + (GDN ? 17408 : 0) + r * 272 + 16 * hh; const unsigned char* sp = base + (GDN ? 53248 : 35840) + r * 144 + 16 * hh;
#define P3_QS1() do { _Pragma("unroll") for (int mt = 0; mt < 2; ++mt) { for (int i = 0; i < 16; ++i) QS[mt][i] = 0.f; \
            _Pragma("unroll") for (int m = 0; m < 4; ++m) _Pragma("unroll") for (int s = 0; s < 2; ++s) { const bf16x8 aq = *(const bf16x8*)(qp + mt * 32 * 272 + 32 * (2 * m + s)); QS[mt] = MFMA32(aq, Sp[m][s], QS[mt]); } } } while (0)
        if constexpr (GDN) {
            const unsigned char* wp = base + r * 272 + 16 * hh; const unsigned char* uT = base + 62464 + r * 144 + 8 * hh;
            f32x16 WS[2];
#pragma unroll
            for (int mt = 0; mt < 2; ++mt) { for (int i = 0; i < 16; ++i) WS[mt][i] = 0.f;
#pragma unroll
                for (int m = 0; m < 4; ++m)
#pragma unroll
                    for (int s = 0; s < 2; ++s) { const bf16x8 aw = *(const bf16x8*)(wp + mt * 32 * 272 + 32 * (2 * m + s)); WS[mt] = MFMA32(aw, Sp[m][s], WS[mt]); } }
            P3_QS1();
#pragma unroll
            for (int mt = 0; mt < 2; ++mt) { f32x16 vn;
#pragma unroll
                for (int g = 0; g < 4; ++g) { const u32x2 u4 = *(const u32x2*)(uT + 2 * (32 * mt + 8 * g));
                    vn[4 * g] = bflo(u4.x) - WS[mt][4 * g]; vn[4 * g + 1] = bfhi(u4.x) - WS[mt][4 * g + 1]; vn[4 * g + 2] = bflo(u4.y) - WS[mt][4 * g + 2]; vn[4 * g + 3] = bfhi(u4.y) - WS[mt][4 * g + 3]; }
                Vp[mt][0] = pack8(vn, 0); Vp[mt][1] = pack8(vn, 1); }
        } else {
            const unsigned char* vT = base + 45568 + r * 144 + 16 * hh;
#pragma unroll
            for (int mt2 = 0; mt2 < 2; ++mt2)
#pragma unroll
                for (int s = 0; s < 2; ++s) Vp[mt2][s] = *(const bf16x8*)(vT + 32 * (2 * mt2 + s));
            P3_QS1();
        }
#undef P3_QS1
        SB();
        {
            const unsigned char* kp = base + (GDN ? 34816 : 17408) + r * 144 + 16 * hh;
            float gl = 1.f; if constexpr (GDN) gl = *(const float*)(base + 256);
#pragma unroll
            for (int m = 0; m < 4; ++m) {
                if constexpr (GDN) S[m] = S[m] * gl;
                else {
#pragma unroll
                    for (int g = 0; g < 4; ++g) { const f32x4 d4 = *(const f32x4*)(base + 45056 + 4 * (32 * m + 8 * g + 4 * hh)); S[m][4 * g] *= d4.x; S[m][4 * g + 1] *= d4.y; S[m][4 * g + 2] *= d4.z; S[m][4 * g + 3] *= d4.w; } }
#pragma unroll
                for (int mt2 = 0; mt2 < 2; ++mt2)
#pragma unroll
                    for (int s = 0; s < 2; ++s) { const bf16x8 aa = *(const bf16x8*)(kp + m * 32 * 144 + 32 * (2 * mt2 + s)); S[m] = MFMA32(aa, Vp[mt2][s], S[m]); } }
#pragma unroll
            for (int mt = 0; mt < 2; ++mt)
#pragma unroll
                for (int mt2 = 0; mt2 <= mt; ++mt2)
#pragma unroll
                    for (int s = 0; s < 2; ++s) { const bf16x8 aa = *(const bf16x8*)(sp + mt * 32 * 144 + 32 * (2 * mt2 + s)); QS[mt] = MFMA32(aa, Vp[mt2][s], QS[mt]); }
        }
        if (c > 0) {
            bf16* orow = O + (size_t)(b * SEQ + (c - 1) * 64) * DM;
#pragma unroll
            for (int mt = 0; mt < 2; ++mt)
#pragma unroll
                for (int i = 0; i < 16; ++i) orow[(size_t)(32 * mt + crow(i, hh)) * DM] = f2bf(QS[mt][i]);
        }
        P3_BAR();
    }
    __builtin_amdgcn_s_setprio(0);
}

#define DPPF(v, ctrl) __int_as_float(__builtin_amdgcn_update_dpp(0, __float_as_int(v), (ctrl), 0xF, 0xF, true))
DI float sum16(float v) {
    v += DPPF(v, 0xB1); v += DPPF(v, 0x4E); v += DPPF(v, 0x141); v += DPPF(v, 0x140); return v;
}
DI void p4_rows2(const Args& a, int row, int lane) {
    bf16* O = (bf16*)(a.ws + WS_NBUF) + (size_t)row * DM; const bf16* pr = (const bf16*)(a.ws + WS_PROJ) + (size_t)row * PROJ_LD;
    u32x4 ov[2][4], gv[2][4]; f32x4 wv[4][2];
#pragma unroll
    for (int rr = 0; rr < 2; ++rr)
#pragma unroll
        for (int j = 0; j < 4; ++j) { const int col = 8 * lane + 512 * j;
            ov[rr][j] = *(const u32x4*)(O + (size_t)rr * DM + col);
            gv[rr][j] = *(const u32x4*)(pr + (size_t)rr * PROJ_LD + (j < 2 ? 3072 + col : 6144 + (col - 1024))); }
#pragma unroll
    for (int j = 0; j < 4; ++j) { const int col = 8 * lane + 512 * j; const float* nw = j < 2 ? a.in[7] + (col & 127) : a.in[10] + ((col - 1024) & 255);
        wv[j][0] = *(const f32x4*)nw; wv[j][1] = *(const f32x4*)(nw + 4); }
#pragma unroll
    for (int rr = 0; rr < 2; ++rr)
#pragma unroll
        for (int j = 0; j < 4; ++j) {
            const int col = 8 * lane + 512 * j; const u32x4 o4 = ov[rr][j], g4 = gv[rr][j];
            float o[8] = {bflo(o4.x), bfhi(o4.x), bflo(o4.y), bfhi(o4.y), bflo(o4.z), bfhi(o4.z), bflo(o4.w), bfhi(o4.w)};
            float g[8] = {bflo(g4.x), bfhi(g4.x), bflo(g4.y), bfhi(g4.y), bflo(g4.z), bfhi(g4.z), bflo(g4.w), bfhi(g4.w)};
            float w[8] = {wv[j][0].x, wv[j][0].y, wv[j][0].z, wv[j][0].w, wv[j][1].x, wv[j][1].y, wv[j][1].z, wv[j][1].w};
            float ss = 0.f;
#pragma unroll
            for (int e = 0; e < 8; ++e) ss += o[e] * o[e];
            ss = sum16(ss);
            float rn;
            if (j < 2) rn = rsqrtf(ss * (1.f / 128.f) + EPS);
            else { ss += __shfl_xor(ss, 16); rn = rsqrtf(ss * (1.f / 256.f) + EPS); }
            float y[8];
#pragma unroll
            for (int e = 0; e < 8; ++e) y[e] = o[e] * rn * w[e] * silu_f(g[e]);
            u32x4 res; res.x = pk2(y[0], y[1]); res.y = pk2(y[2], y[3]); res.z = pk2(y[4], y[5]); res.w = pk2(y[6], y[7]);
            *(u32x4*)(O + (size_t)rr * DM + col) = res;
        }
}

#define LAS __attribute__((address_space(3)))
#define XB_TMO      128
#define XB_XCNT(j)  (256  + 64 * (j))
#define XB_XSUB(j)  (1280 + 64 * (j))
#define XB_XGEN(j)  (2304 + 64 * (j))
#define XB_TOP      3328
#define XB_TOPGEN   3392
#define XCD_BAR_WORDS 3456
#define XB_SPIN_CAP (1u << 18)

__device__ __forceinline__ unsigned xb_ld(unsigned* p)              { return __hip_atomic_load(p, __ATOMIC_RELAXED, __HIP_MEMORY_SCOPE_AGENT); }
__device__ __forceinline__ unsigned xb_add(unsigned* p, unsigned v) { return __hip_atomic_fetch_add(p, v, __ATOMIC_RELAXED, __HIP_MEMORY_SCOPE_AGENT); }
__device__ __forceinline__ unsigned xb_xcc_id() { return (unsigned)__builtin_amdgcn_s_getreg((3 << 11) | 20) & 0xFu; }
#define XB_SPIN(cond, bar) do { unsigned _sp = 0; while (cond) { __builtin_amdgcn_s_sleep(1); \
    if ((++_sp & 255u) == 0u) { if (xb_ld(&(bar)[XB_TMO])) break; if (_sp > XB_SPIN_CAP) { atomicAdd(&(bar)[XB_TMO], 1u); break; } } } } while (0)

struct XcdBarrier {
    unsigned* bar; unsigned x;
    volatile LAS unsigned* st;
};

__device__ __forceinline__ XcdBarrier xcd_barrier_post(unsigned* bar, volatile LAS unsigned* st) {
    XcdBarrier b; b.bar = bar; b.x = xb_xcc_id(); b.st = st;
    if (threadIdx.x == 0) (void)xb_add(&bar[XB_XCNT(b.x)], 1u);
    return b;
}
__device__ __forceinline__ void xcd_barrier_complete(unsigned* bar, unsigned x, unsigned& nloc, unsigned& nx) {
    const unsigned G = gridDim.x * gridDim.y * gridDim.z;
    unsigned sum, cnt, mine, sp = 0u;
    for (;;) {
        sum = 0u; cnt = 0u; mine = 0u;
#pragma unroll
        for (unsigned j = 0; j < 16; ++j) { const unsigned c = xb_ld(&bar[XB_XCNT(j)]); sum += c; cnt += (c > 0u) ? 1u : 0u; mine = (j == x) ? c : mine; }
        if (sum == G) break;
        __builtin_amdgcn_s_sleep(1);
        if ((++sp & 255u) == 0u) { if (xb_ld(&bar[XB_TMO])) break; if (sp > XB_SPIN_CAP) { atomicAdd(&bar[XB_TMO], 1u); break; } }
    }
    nloc = mine > 0u ? mine : 1u; nx = cnt > 0u ? cnt : 1u;
}

__device__ __forceinline__ void xcd_barrier(const XcdBarrier& b) {
    asm volatile("s_waitcnt vmcnt(0)" ::: "memory");
    __syncthreads();
    if (threadIdx.x == 0) {
        unsigned* bar = b.bar;
        __builtin_amdgcn_s_waitcnt(0);
        unsigned nloc = b.st[0], nx = b.st[1];
        if (nloc == 0u) { xcd_barrier_complete(bar, b.x, nloc, nx); b.st[0] = nloc; b.st[1] = nx; }
        const unsigned old = xb_add(&bar[XB_XSUB(b.x)], 1u);
        const unsigned gen = old / nloc;
        if (old + 1u == (gen + 1u) * nloc) {
            __builtin_amdgcn_fence(__ATOMIC_RELEASE, "agent");
            asm volatile("s_waitcnt vmcnt(0)" ::: "memory");
            const unsigned og = xb_add(&bar[XB_TOP], 1u);
            const unsigned tg = og / nx;
            if (og + 1u == (tg + 1u) * nx) xb_add(&bar[XB_TOPGEN], 1u);
            else XB_SPIN(xb_ld(&bar[XB_TOPGEN]) == tg, bar);
            __builtin_amdgcn_fence(__ATOMIC_ACQUIRE, "agent");
            xb_add(&bar[XB_XGEN(b.x)], 1u);
            asm volatile("s_waitcnt vmcnt(0)" ::: "memory");
        } else {
            XB_SPIN(xb_ld(&bar[XB_XGEN(b.x)]) == gen, bar);
            __builtin_amdgcn_fence(__ATOMIC_ACQUIRE, "agent");
            asm volatile("s_waitcnt vmcnt(0)" ::: "memory");
        }
    }
    __syncthreads();
}

__global__ void __launch_bounds__(512, 2) mk_fwd(Args a) {
    extern __shared__ __attribute__((aligned(16))) unsigned char lds[];
    cg::grid_group grid = cg::this_grid();
    const int tid = threadIdx.x, lane = tid & 63, wave = __builtin_amdgcn_readfirstlane(tid >> 6), G = gridDim.x, bx = blockIdx.x;
    const int gw = bx * 8 + wave, NGW = G * 8;
    unsigned char* ws = a.ws;
    PG8_LAS unsigned char* ring = (PG8_LAS unsigned char*)lds;
    const int lo = a.ph_lo, hi = a.ph_hi;
#ifndef SKIPMASK
#define SKIPMASK 0
#endif
#define IN(k) (!((SKIPMASK >> (k)) & 1) && lo <= (k) && (k) < hi)
#ifndef REP2
#define REP2 1
#endif
#ifndef REP3
#define REP3 1
#endif
#ifndef REP7
#define REP7 1
#endif
#define SEAM(k) do { if (IN(k) && IN((k) + 1)) xcd_barrier(bar); } while (0)
#ifdef XSYNC
    for (int q_ = 0; q_ < XSYNC; ++q_) grid.sync();
#endif
#ifdef REP0
    if (IN(0)) p0_prep(a, lds, tid, G);
    __syncthreads();
#endif
    volatile LAS unsigned* bst = (volatile LAS unsigned*)((LAS unsigned char*)lds + 147456);
    if (tid == 0) { bst[0] = 0u; bst[1] = 0u; }
    __syncthreads();
    if (IN(0)) p0_prep(a, lds, tid, G);
    if (bx == 0) { unsigned* bw = (unsigned*)(ws + WS_GL); for (int i = tid; i < XCD_BAR_WORDS; i += 512) bw[i] = 0u; }
    grid.sync();
    XcdBarrier bar = xcd_barrier_post((unsigned*)(ws + WS_GL), bst);
    if (IN(1)) {
        pg8::Gemm g{(const pg8::bf16_t*)(ws + WS_NBUF), (const pg8::bf16_t*)(ws + WS_WIN), MX, PROJ_LD, DM}; pg8::StaticOrder S; S.init(MX, PROJ_LD, G, bx);
        pg8::EpiProj E{(pg8::bf16_t*)(ws + WS_PROJ), (float*)(ws + WS_SMALL)};
        pg8::gemm_phase<pg8::EpiProj, pg8::StaticOrder, true, true>(ring, g, S, E);
        p1_tail(a, lds, tid, bx, G);
    }
    SEAM(1);
    if (IN(2)) {
        { const int h0 = bx & 7; float* cwl = (float*)(lds + 141312); for (int i = tid; i < 4 * 384; i += 512) { const int tap = i / 384, ch = i % 384; cwl[i] = a.in[4][tap * 3072 + (ch >> 7) * 1024 + h0 * 128 + (ch & 127)]; } }
        if (bx < 4128) { gdn_stage_raw(a, lds, bx, tid, 512); if (wave == 0) gdn_gates(a, (float*)(lds + 140288), bx, lane); }
        LBAR();
        { int par = 0; for (int it = bx; it < 4128; it += G, par ^= 1) {
            if ((G & 7) && it != bx) { LBAR(); const int h0 = it & 7; float* cwl = (float*)(lds + 141312); for (int i = tid; i < 4 * 384; i += 512) { const int tap = i / 384, ch = i % 384; cwl[i] = a.in[4][tap * 3072 + (ch >> 7) * 1024 + h0 * 128 + (ch & 127)]; } LBAR(); }
            p2_gdn_item(a, lds, it, it + G < 4128 ? it + G : -1, par, tid); } }
        for (int it = G - 1 - bx; it < 2064; it += G) p2_gla_item(a, lds, it, tid);
#ifdef REPGLA
        for (int it = G - 1 - bx; it < 2064; it += G) p2_gla_item(a, lds, it, tid);
#endif
    }
#if REP2 > 1
    __syncthreads();
    if (IN(2)) {
        { const int h0 = bx & 7; float* cwl = (float*)(lds + 141312); for (int i = tid; i < 4 * 384; i += 512) { const int tap = i / 384, ch = i % 384; cwl[i] = a.in[4][tap * 3072 + (ch >> 7) * 1024 + h0 * 128 + (ch & 127)]; } }
        if (bx < 4128) { gdn_stage_raw(a, lds, bx, tid, 512); if (wave == 0) gdn_gates(a, (float*)(lds + 140288), bx, lane); }
        LBAR();
        { int par = 0; for (int it = bx; it < 4128; it += G, par ^= 1) {
            if ((G & 7) && it != bx) { LBAR(); const int h0 = it & 7; float* cwl = (float*)(lds + 141312); for (int i = tid; i < 4 * 384; i += 512) { const int tap = i / 384, ch = i % 384; cwl[i] = a.in[4][tap * 3072 + (ch >> 7) * 1024 + h0 * 128 + (ch & 127)]; } LBAR(); }
            p2_gdn_item(a, lds, it, it + G < 4128 ? it + G : -1, par, tid); } }
        for (int it = G - 1 - bx; it < 2064; it += G) p2_gla_item(a, lds, it, tid);
    }
#endif
    SEAM(2);
    if (IN(3)) {
        for (int u = bx; u < 256; u += G) {
            const int x = u & 7, j = u >> 3;
            if (j < 16) p3_scan<true>(a, lds, 4 * x + (j >> 2), j & 3, tid);
            else p3_scan<false>(a, lds, 2 * x + ((j - 16) >> 3), (j - 16) & 7, tid);
            __syncthreads();
        }
    }
#if REP3 > 1
    __syncthreads();
    if (IN(3)) {
        for (int u = bx; u < 256; u += G) {
            const int x = u & 7, j = u >> 3;
            if (j < 16) p3_scan<true>(a, lds, 4 * x + (j >> 2), j & 3, tid);
            else p3_scan<false>(a, lds, 2 * x + ((j - 16) >> 3), (j - 16) & 7, tid);
            __syncthreads();
        }
    }
#endif
    SEAM(3);
    if (IN(4)) for (int row = 2 * gw; row < MX; row += 2 * NGW) p4_rows2(a, row, lane);
    SEAM(4);
    if (IN(5)) {
        pg8::Gemm g{(const pg8::bf16_t*)(ws + WS_NBUF), (const pg8::bf16_t*)(ws + WS_WOUT), MX, DM, DM}; pg8::StaticOrder S; S.init(MX, DM, G, bx);
        pg8::EpiResF2B E{a.in[0], (pg8::bf16_t*)(ws + WS_GDN), (float*)(ws + WS_SMALL)};
        pg8::gemm_phase<pg8::EpiResF2B, pg8::StaticOrder, true, true>(ring, g, S, E);
    }
    SEAM(5);
    if (IN(6)) for (int row = bx * 512 + tid; row < MX; row += G * 512) {
        const f32x4* pp = (const f32x4*)(ws + WS_SMALL) + (size_t)row * 8; float t = 0.f;
#pragma unroll
        for (int j = 0; j < 8; ++j) { const f32x4 v = pp[j]; t += (v.x + v.y) + (v.z + v.w); }
        ((float*)(ws + WS_GL + 65536))[row] = rsqrtf(t * (1.f / DM) + EPS);
    }
    SEAM(6);
    if (IN(7)) {
        pg8::Gemm g{(const pg8::bf16_t*)(ws + WS_GDN), (const pg8::bf16_t*)(ws + WS_WGU), MX, 2 * DFF, DM}; pg8::StaticOrder S; S.init(MX, 2 * DFF, G, bx);
        pg8::EpiSwiGLUr E{(pg8::bf16_t*)(ws + WS_PROJ), (const float*)(ws + WS_GL + 65536)};
        pg8::gemm_phase<pg8::EpiSwiGLUr, pg8::StaticOrder, true, true>(ring, g, S, E);
    }
#if REP7 > 1
    __syncthreads();
    if (IN(7)) {
        pg8::Gemm g{(const pg8::bf16_t*)(ws + WS_GDN), (const pg8::bf16_t*)(ws + WS_WGU), MX, 2 * DFF, DM}; pg8::StaticOrder S; S.init(MX, 2 * DFF, G, bx);
        pg8::EpiSwiGLUr E{(pg8::bf16_t*)(ws + WS_PROJ), (const float*)(ws + WS_GL + 65536)};
        pg8::gemm_phase<pg8::EpiSwiGLUr, pg8::StaticOrder, true, true>(ring, g, S, E);
    }
#endif
    SEAM(7);
    if (IN(8)) {
        pg8::Gemm g{(const pg8::bf16_t*)(ws + WS_PROJ), (const pg8::bf16_t*)(ws + WS_WDN), MX, DM, DFF}; pg8::StaticOrder S; S.init(MX, DM, G, bx);
        pg8::EpiResB2B E{(const pg8::bf16_t*)(ws + WS_GDN), (pg8::bf16_t*)(ws + WS_NBUF)};
        pg8::gemm_phase<pg8::EpiResB2B, pg8::StaticOrder, true, true>(ring, g, S, E);
    }
    SEAM(8);
    if (IN(9)) for (int row = 2 * gw; row < MX; row += 2 * NGW) rms_rows2_b2f((const bf16*)(ws + WS_NBUF) + (size_t)row * DM, (const bf16*)(ws + WS_NBUF) + (size_t)(row + 1) * DM, a.in[16], a.out + (size_t)row * DM, a.out + (size_t)(row + 1) * DM, lane);
#undef IN
#undef SEAM
}

extern "C" void kernel_launch(void* const* d_in, const int* in_sizes, int n_in, void* d_out, int out_size, void* d_ws, size_t ws_size, hipStream_t stream) {
    static int grid = 0;
    if (grid == 0) {
        int dev = 0, cus = 0, per_cu = 0;
        if (n_in != 17 || out_size != MX * DM || ws_size < WS_END) { fprintf(stderr, "kernel_launch: unexpected shapes (n_in %d out %d ws %zu)\n", n_in, out_size, ws_size); grid = -1; return; }
        (void)hipGetDevice(&dev);
        (void)hipDeviceGetAttribute(&cus, hipDeviceAttributeMultiprocessorCount, dev);
        (void)hipFuncSetAttribute((const void*)mk_fwd, hipFuncAttributeMaxDynamicSharedMemorySize, LDS_BYTES);
        (void)hipOccupancyMaxActiveBlocksPerMultiprocessor(&per_cu, (const void*)mk_fwd, 512, LDS_BYTES);
        if (per_cu < 1) per_cu = 1;
        grid = cus * per_cu;
    }
    if (grid < 0) return;
    Args a{};
    for (int i = 0; i < 17; ++i) a.in[i] = (const float*)d_in[i];
    a.out = (float*)d_out; a.ws = (unsigned char*)d_ws; a.ph_lo = 0; a.ph_hi = 10;
    void* args[] = {&a};
    hipError_t e = hipLaunchCooperativeKernel((const void*)mk_fwd, dim3(grid), dim3(512), args, LDS_BYTES, stream);
    if (e != hipSuccess) fprintf(stderr, "cooperative launch failed: %s (grid %d)\n", hipGetErrorString(e), grid);
}
```

```cpp
#include <hip/hip_runtime.h>
#include <hip/hip_cooperative_groups.h>
#include <cstdio>
#include <cstdint>
namespace cg = cooperative_groups;
namespace pg8 {
#define PG8_LAS __attribute__((address_space(3)))
typedef unsigned short bf16_t;
typedef short bf16x8 __attribute__((ext_vector_type(8)));
typedef float f32x4 __attribute__((ext_vector_type(4)));
typedef unsigned u32x4 __attribute__((ext_vector_type(4)));
constexpr int BM = 256, BK = 64, HALF = 128, HTB = HALF * BK * 2  , STAGE_BYTES = 8 * HTB, NXCD = 8, WGM = 8;

__host__ __device__ __forceinline__ int lds_byte(int r, int c) { const int st = (r >> 4) * 2 + (c >> 5), rr = r & 15, cc = c & 31, ob = rr * 64 + cc * 2; return st * 1024 + (ob ^ (((ob >> 9) & 1) << 5)); }
__host__ __device__ __forceinline__ void stage_rc(int b, int& R, int& C) { const int st = b / 1024, sb = b % 1024, swz = sb ^ (((sb >> 9) & 1) << 5); R = (st >> 1) * 16 + swz / 64; C = (st & 1) * 32 + (swz % 64) / 2; }
__host__ __device__ __forceinline__ int perm32(int rho) { const int n = rho >> 4, i = rho & 15; return 8 * (i >> 2) + 4 * n + (i & 3); }

struct Unit { int pm, pn; };
struct Gemm { const bf16_t* A; const bf16_t* Bt; int M, N, K; };

struct StaticOrder {
    int nM, nN, nwg, G, c;
    __host__ __device__ void init(int M, int N, int G_, int c_) { nM = M / BM; nN = N / BM; nwg = nM * nN; G = G_; c = c_; }
    __host__ __device__ bool next(int i, Unit& u) const {
        const long L = (long)i * G + c; if (L >= nwg) return false;
        int wgid = (int)L; { const int q = nwg / NXCD, r = nwg % NXCD, xcd = wgid % NXCD, off = wgid / NXCD; wgid = (xcd < r ? xcd * (q + 1) : r * (q + 1) + (xcd - r) * q) + off; }
        const int nig = WGM * nN, gid = wgid / nig, fm = gid * WGM, gsz = (nM - fm) < WGM ? (nM - fm) : WGM;
        u.pm = fm + ((wgid % nig) % gsz); u.pn = (wgid % nig) / gsz; return true;
    }
    __device__ __forceinline__ void a_ready(const Unit&) const {}
    __device__ __forceinline__ void done(const Unit&) const {}
};

__device__ __forceinline__ unsigned cvt_pk_bf16(float lo, float hi) { unsigned r; asm volatile("v_cvt_pk_bf16_f32 %0, %1, %2" : "=v"(r) : "v"(lo), "v"(hi)); return r; }
typedef float f32x2 __attribute__((ext_vector_type(2)));
__device__ __forceinline__ float silu_f(float g) { return g * __builtin_amdgcn_rcpf(1.0f + __expf(-g)); }
struct EpiProj {
    static constexpr bool PERM = true, AFTER_DRAIN = false;
    bf16_t* O; float* Sm;
    __device__ __forceinline__ void operator()(const f32x4 (&acc)[2][2][4][2], const Unit& u, int wr, int wc, int fr, int fq) const {
        const int row0 = u.pm * BM + wr * 64 + fr;
        if (u.pn < 28) {
            const int col0 = u.pn * BM + wc * 32 + 8 * fq;
#pragma unroll
            for (int ai = 0; ai < 2; ++ai)
#pragma unroll
                for (int m = 0; m < 4; ++m) { bf16_t* rowp = O + (size_t)(row0 + ai * HALF + m * 16) * 7168 + col0;
#pragma unroll
                    for (int bj = 0; bj < 2; ++bj) { const f32x4 v0 = acc[ai][bj][m][0], v1 = acc[ai][bj][m][1];
                        u32x4 w; w.x = cvt_pk_bf16(v0[0], v0[1]); w.y = cvt_pk_bf16(v0[2], v0[3]); w.z = cvt_pk_bf16(v1[0], v1[1]); w.w = cvt_pk_bf16(v1[2], v1[3]);
                        *(u32x4*)(rowp + bj * HALF) = w; } }
        } else if (wc == 0) {
#pragma unroll
            for (int ai = 0; ai < 2; ++ai)
#pragma unroll
                for (int m = 0; m < 4; ++m) { float* rp = Sm + (size_t)(row0 + ai * HALF + m * 16) * 32 + 8 * fq;
                    *(f32x4*)rp = acc[ai][0][m][0]; *(f32x4*)(rp + 4) = acc[ai][0][m][1]; }
        }
    }
};
struct EpiRes {
    static constexpr bool PERM = true, AFTER_DRAIN = false;
    const float* base; float* out;
    __device__ __forceinline__ void operator()(const f32x4 (&acc)[2][2][4][2], const Unit& u, int wr, int wc, int fr, int fq) const {
        const int row0 = u.pm * BM + wr * 64 + fr, col0 = u.pn * BM + wc * 32 + 8 * fq;
#pragma unroll
        for (int ai = 0; ai < 2; ++ai)
#pragma unroll
            for (int m = 0; m < 4; ++m) { const size_t off = (size_t)(row0 + ai * HALF + m * 16) * 2048 + col0;
#pragma unroll
                for (int bj = 0; bj < 2; ++bj)
#pragma unroll
                    for (int n = 0; n < 2; ++n) { const f32x4 b4 = *(const f32x4*)(base + off + bj * HALF + 4 * n); *(f32x4*)(out + off + bj * HALF + 4 * n) = b4 + acc[ai][bj][m][n]; } }
    }
};
struct EpiSwiGLU {
    static constexpr bool PERM = true, AFTER_DRAIN = false;
    bf16_t* O;
    __device__ __forceinline__ void operator()(const f32x4 (&acc)[2][2][4][2], const Unit& u, int wr, int wc, int fr, int fq) const {
        const int row0 = u.pm * BM + wr * 64 + fr, col0 = u.pn * 128 + wc * 32 + 8 * fq;
#pragma unroll
        for (int ai = 0; ai < 2; ++ai)
#pragma unroll
            for (int m = 0; m < 4; ++m) { bf16_t* rowp = O + (size_t)(row0 + ai * HALF + m * 16) * 5632 + col0;
                const f32x4 g0 = acc[ai][0][m][0], g1 = acc[ai][0][m][1], u0 = acc[ai][1][m][0], u1 = acc[ai][1][m][1];
                u32x4 w; w.x = cvt_pk_bf16(silu_f(g0[0]) * u0[0], silu_f(g0[1]) * u0[1]); w.y = cvt_pk_bf16(silu_f(g0[2]) * u0[2], silu_f(g0[3]) * u0[3]);
                w.z = cvt_pk_bf16(silu_f(g1[0]) * u1[0], silu_f(g1[1]) * u1[1]); w.w = cvt_pk_bf16(silu_f(g1[2]) * u1[2], silu_f(g1[3]) * u1[3]);
                *(u32x4*)rowp = w; }
    }
};
struct EpiResF2B {
    static constexpr bool PERM = true, AFTER_DRAIN = false;
    const float* base; bf16_t* out; float* ssp;
    __device__ __forceinline__ void operator()(const f32x4 (&acc)[2][2][4][2], const Unit& u, int wr, int wc, int fr, int fq) const {
        const int row0 = u.pm * BM + wr * 64 + fr, col0 = u.pn * BM + wc * 32 + 8 * fq;
#pragma unroll
        for (int ai = 0; ai < 2; ++ai)
#pragma unroll
            for (int m = 0; m < 4; ++m) { const int row = row0 + ai * HALF + m * 16; const size_t off = (size_t)row * 2048 + col0; float ss = 0.f;
#pragma unroll
                for (int bj = 0; bj < 2; ++bj) { const f32x4 v0 = *(const f32x4*)(base + off + bj * HALF) + acc[ai][bj][m][0], v1 = *(const f32x4*)(base + off + bj * HALF + 4) + acc[ai][bj][m][1];
                    ss += (v0[0] * v0[0] + v0[1] * v0[1]) + (v0[2] * v0[2] + v0[3] * v0[3]) + (v1[0] * v1[0] + v1[1] * v1[1]) + (v1[2] * v1[2] + v1[3] * v1[3]);
                    u32x4 w; w.x = cvt_pk_bf16(v0[0], v0[1]); w.y = cvt_pk_bf16(v0[2], v0[3]); w.z = cvt_pk_bf16(v1[0], v1[1]); w.w = cvt_pk_bf16(v1[2], v1[3]);
                    *(u32x4*)(out + off + bj * HALF) = w; }
                ss += __shfl_xor(ss, 16); ss += __shfl_xor(ss, 32);
                if (fq == 0) ssp[(size_t)row * 32 + 4 * u.pn + wc] = ss; }
    }
};
struct EpiResB2B {
    static constexpr bool PERM = true, AFTER_DRAIN = false;
    const bf16_t* base; bf16_t* out;
    __device__ __forceinline__ void operator()(const f32x4 (&acc)[2][2][4][2], const Unit& u, int wr, int wc, int fr, int fq) const {
        const int row0 = u.pm * BM + wr * 64 + fr, col0 = u.pn * BM + wc * 32 + 8 * fq;
#pragma unroll
        for (int ai = 0; ai < 2; ++ai)
#pragma unroll
            for (int m = 0; m < 4; ++m) { const size_t off = (size_t)(row0 + ai * HALF + m * 16) * 2048 + col0;
#pragma unroll
                for (int bj = 0; bj < 2; ++bj) { const u32x4 b4 = *(const u32x4*)(base + off + bj * HALF);
                    const f32x4 v0 = (f32x4){__uint_as_float(b4.x << 16), __uint_as_float(b4.x & 0xffff0000u), __uint_as_float(b4.y << 16), __uint_as_float(b4.y & 0xffff0000u)} + acc[ai][bj][m][0];
                    const f32x4 v1 = (f32x4){__uint_as_float(b4.z << 16), __uint_as_float(b4.z & 0xffff0000u), __uint_as_float(b4.w << 16), __uint_as_float(b4.w & 0xffff0000u)} + acc[ai][bj][m][1];
                    u32x4 w; w.x = cvt_pk_bf16(v0[0], v0[1]); w.y = cvt_pk_bf16(v0[2], v0[3]); w.z = cvt_pk_bf16(v1[0], v1[1]); w.w = cvt_pk_bf16(v1[2], v1[3]);
                    *(u32x4*)(out + off + bj * HALF) = w; } }
    }
};
struct EpiSwiGLUr {
    static constexpr bool PERM = true, AFTER_DRAIN = false;
    bf16_t* O; const float* rstd;
    __device__ __forceinline__ void operator()(const f32x4 (&acc)[2][2][4][2], const Unit& u, int wr, int wc, int fr, int fq) const {
        const int row0 = u.pm * BM + wr * 64 + fr, col0 = u.pn * 128 + wc * 32 + 8 * fq;
#pragma unroll
        for (int ai = 0; ai < 2; ++ai)
#pragma unroll
            for (int m = 0; m < 4; ++m) { const int row = row0 + ai * HALF + m * 16; bf16_t* rowp = O + (size_t)row * 5632 + col0;
                const float rs = rstd[row];
                const f32x4 g0 = acc[ai][0][m][0] * rs, g1 = acc[ai][0][m][1] * rs, u0 = acc[ai][1][m][0] * rs, u1 = acc[ai][1][m][1] * rs;
                u32x4 w; w.x = cvt_pk_bf16(silu_f(g0[0]) * u0[0], silu_f(g0[1]) * u0[1]); w.y = cvt_pk_bf16(silu_f(g0[2]) * u0[2], silu_f(g0[3]) * u0[3]);
                w.z = cvt_pk_bf16(silu_f(g1[0]) * u1[0], silu_f(g1[1]) * u1[1]); w.w = cvt_pk_bf16(silu_f(g1[2]) * u1[2], silu_f(g1[3]) * u1[3]);
                *(u32x4*)rowp = w; }
    }
};
template <class Epi, class Sched, bool ALIGN_EPI = false, bool SP2 = false>
__device__ __forceinline__ void gemm_phase(PG8_LAS unsigned char* lds, const Gemm g, const Sched& S, const Epi& E) {
    const int tid = threadIdx.x, wid = __builtin_amdgcn_readfirstlane(tid >> 6), lane = tid & 63, wr = wid >> 2, wc = wid & 3, fr = lane & 15, fq = lane >> 4;
    const int K = g.K, nt = K / BK;
    unsigned voffA[2], voffB[2];
#pragma unroll
    for (int i = 0; i < 2; ++i) { int R, C; stage_rc(tid * 16 + i * 8192, R, C); const int Rb = Epi::PERM ? ((R & ~31) + perm32(R & 31)) : R;
        voffA[i] = (unsigned)(R * K + C) * 2u; voffB[i] = (unsigned)(Rb * K + C) * 2u; }
    const size_t kstep = (size_t)(BK * 2);
    const size_t hstep = (size_t)HALF * K * 2;
    const size_t tstep = 2 * hstep;
    const unsigned ldsw = (unsigned)wid * 1024u;
    const int aoff = lds_byte(wr * 64 + fr, fq * 8), boff = lds_byte(wc * 32 + fr, fq * 8);
#define PG8_SA(b, h) (((b) * 2 + (h)) * HTB)
#define PG8_SB(b, h) ((4 + (b) * 2 + (h)) * HTB)
#define PG8_STAGE(bufoff, gbase, voff) do { _Pragma("unroll") for (int _i = 0; _i < 2; ++_i) \
        __builtin_amdgcn_global_load_lds((const unsigned*)((const char*)(gbase) + (voff)[_i]), (PG8_LAS unsigned*)(lds + (bufoff) + ldsw + _i * 8192), 16, 0, 0); } while (0)
#define PG8_LDA(dst, b, h) do { _Pragma("unroll") for (int m = 0; m < 4; ++m) _Pragma("unroll") for (int k = 0; k < 2; ++k) dst[m][k] = *(const PG8_LAS bf16x8*)(lds + PG8_SA(b, h) + aoff + m * 2048 + k * 1024); } while (0)
#define PG8_LDB(dst, b, h) do { _Pragma("unroll") for (int n = 0; n < 2; ++n) _Pragma("unroll") for (int k = 0; k < 2; ++k) dst[n][k] = *(const PG8_LAS bf16x8*)(lds + PG8_SB(b, h) + boff + n * 2048 + k * 1024); } while (0)
#define PG8_MMA(ai, bj, At, Bt) do { __builtin_amdgcn_s_setprio(1); _Pragma("unroll") for (int m = 0; m < 4; ++m) _Pragma("unroll") for (int n = 0; n < 2; ++n) _Pragma("unroll") for (int k = 0; k < 2; ++k) \
        acc[ai][bj][m][n] = __builtin_amdgcn_mfma_f32_16x16x32_bf16(Bt[n][k], At[m][k], acc[ai][bj][m][n], 0, 0, 0); __builtin_amdgcn_s_setprio(0); } while (0)
#define PG8_WAIT_V(n) asm volatile("s_waitcnt vmcnt(" #n ")" ::: "memory")
#define PG8_WAIT_L(n) asm volatile("s_waitcnt lgkmcnt(" #n ")" ::: "memory")
#define PG8_BAR __builtin_amdgcn_s_barrier()
#define PG8_SCHED __builtin_amdgcn_sched_barrier(0)
    Unit cur, nxt; int ui = 0;
    if (!S.next(0, cur)) return;
    f32x4 acc[2][2][4][2];
#pragma unroll
    for (int a = 0; a < 2; ++a)
#pragma unroll
        for (int b = 0; b < 2; ++b)
#pragma unroll
            for (int m = 0; m < 4; ++m)
#pragma unroll
                for (int n = 0; n < 2; ++n) acc[a][b][m][n] = (f32x4){0.f, 0.f, 0.f, 0.f};
    bf16x8 At[4][2], B0[2][2], B1[2][2];
    const char* cA = (const char*)g.A + (size_t)cur.pm * tstep; const char* cB = (const char*)g.Bt + (size_t)cur.pn * tstep;
    S.a_ready(cur);
    if constexpr (SP2) {
        PG8_STAGE(PG8_SB(0, 0), cB, voffB); PG8_STAGE(PG8_SB(0, 1), cB + hstep, voffB); PG8_STAGE(PG8_SA(0, 0), cA, voffA); PG8_STAGE(PG8_SA(0, 1), cA + hstep, voffA);
        if (wr == 1) PG8_BAR;
        PG8_WAIT_V(2); PG8_BAR;
        PG8_STAGE(PG8_SB(1, 0), cB + kstep, voffB); PG8_STAGE(PG8_SA(1, 0), cA + kstep, voffA); PG8_STAGE(PG8_SB(1, 1), cB + hstep + kstep, voffB);
        PG8_WAIT_V(6); PG8_BAR;
    } else {
        PG8_STAGE(PG8_SB(0, 0), cB, voffB); PG8_STAGE(PG8_SA(0, 0), cA, voffA); PG8_STAGE(PG8_SB(0, 1), cB + hstep, voffB); PG8_STAGE(PG8_SA(0, 1), cA + hstep, voffA);
        if (wr == 1) PG8_BAR;
        PG8_WAIT_V(4); PG8_BAR;
        PG8_STAGE(PG8_SB(1, 0), cB + kstep, voffB); PG8_STAGE(PG8_SA(1, 0), cA + kstep, voffA); PG8_STAGE(PG8_SB(1, 1), cB + hstep + kstep, voffB);
        PG8_WAIT_V(6); PG8_BAR;
    }
    for (;;) {
        const bool has_next = S.next(ui + 1, nxt);
        const char* nA = has_next ? (const char*)g.A + (size_t)nxt.pm * tstep : cA; const char* nB = has_next ? (const char*)g.Bt + (size_t)nxt.pn * tstep : cB;
        for (int t = 0; t < nt; t += 2) {
            const bool last = (t == nt - 2);
            const char* a1 = cA + (size_t)(t + 1) * kstep;
            const char* a2 = last ? nA : cA + (size_t)(t + 2) * kstep; const char* b2 = last ? nB : cB + (size_t)(t + 2) * kstep;
            const char* a3 = a2 + kstep; const char* b3 = b2 + kstep;
            if (last && has_next) S.a_ready(nxt);
            if constexpr (SP2) {
            PG8_LDB(B0, 0, 0); PG8_LDB(B1, 0, 1); PG8_SCHED; PG8_LDA(At, 0, 0); PG8_STAGE(PG8_SA(1, 1), a1 + hstep, voffA);
            PG8_WAIT_V(8); PG8_WAIT_L(0); PG8_BAR; PG8_MMA(0, 0, At, B0); PG8_MMA(0, 1, At, B1); PG8_BAR; PG8_SCHED;
            PG8_LDA(At, 0, 1); PG8_STAGE(PG8_SB(0, 0), b2, voffB); PG8_STAGE(PG8_SB(0, 1), b2 + hstep, voffB); PG8_STAGE(PG8_SA(0, 0), a2, voffA);
            PG8_WAIT_V(8); PG8_WAIT_L(0); PG8_BAR; PG8_MMA(1, 0, At, B0); PG8_MMA(1, 1, At, B1); PG8_BAR; PG8_SCHED;
            PG8_LDB(B0, 1, 0); PG8_LDB(B1, 1, 1); PG8_SCHED; PG8_LDA(At, 1, 0); PG8_STAGE(PG8_SA(0, 1), a2 + hstep, voffA);
            PG8_WAIT_V(8); PG8_WAIT_L(0); PG8_BAR; PG8_MMA(0, 0, At, B0); PG8_MMA(0, 1, At, B1); PG8_BAR; PG8_SCHED;
            PG8_LDA(At, 1, 1); PG8_STAGE(PG8_SB(1, 0), b3, voffB); PG8_STAGE(PG8_SB(1, 1), b3 + hstep, voffB); PG8_STAGE(PG8_SA(1, 0), a3, voffA);
            PG8_WAIT_V(8); PG8_WAIT_L(0); PG8_BAR; PG8_MMA(1, 0, At, B0); PG8_MMA(1, 1, At, B1); PG8_BAR; PG8_SCHED;
            } else {
            PG8_LDB(B0, 0, 0); PG8_SCHED; PG8_LDA(At, 0, 0); PG8_STAGE(PG8_SA(1, 1), a1 + hstep, voffA);
            PG8_WAIT_L(8); PG8_BAR; PG8_WAIT_L(0); PG8_MMA(0, 0, At, B0); PG8_BAR; PG8_SCHED;
            PG8_LDB(B1, 0, 1); PG8_STAGE(PG8_SB(0, 0), b2, voffB);
            PG8_BAR; PG8_WAIT_L(0); PG8_MMA(0, 1, At, B1); PG8_BAR;
            PG8_LDA(At, 0, 1); PG8_STAGE(PG8_SA(0, 0), a2, voffA);
            PG8_BAR; PG8_WAIT_L(0); PG8_MMA(1, 0, At, B0); PG8_BAR; PG8_SCHED;
            PG8_STAGE(PG8_SB(0, 1), b2 + hstep, voffB);
            PG8_WAIT_V(6); PG8_BAR; PG8_MMA(1, 1, At, B1); PG8_BAR;
            PG8_LDB(B0, 1, 0); PG8_SCHED; PG8_LDA(At, 1, 0); PG8_STAGE(PG8_SA(0, 1), a2 + hstep, voffA);
            PG8_WAIT_L(8); PG8_BAR; PG8_WAIT_L(0); PG8_MMA(0, 0, At, B0); PG8_BAR; PG8_SCHED;
            PG8_LDB(B1, 1, 1); PG8_STAGE(PG8_SB(1, 0), b3, voffB);
            PG8_BAR; PG8_WAIT_L(0); PG8_MMA(0, 1, At, B1); PG8_BAR;
            PG8_LDA(At, 1, 1); PG8_STAGE(PG8_SA(1, 0), a3, voffA);
            PG8_BAR; PG8_WAIT_L(0); PG8_MMA(1, 0, At, B0); PG8_BAR; PG8_SCHED;
            PG8_STAGE(PG8_SB(1, 1), b3 + hstep, voffB);
            PG8_WAIT_V(6); PG8_BAR; PG8_MMA(1, 1, At, B1); PG8_BAR;
            }
        }
        if constexpr (ALIGN_EPI) { if (wr == 0) PG8_BAR; }
        if constexpr (!Epi::AFTER_DRAIN) { E(acc, cur, wr, wc, fr, fq); S.done(cur); }
        if (!has_next) break;
#pragma unroll
        for (int a = 0; a < 2; ++a)
#pragma unroll
            for (int b = 0; b < 2; ++b)
#pragma unroll
                for (int m = 0; m < 4; ++m)
#pragma unroll
                    for (int n = 0; n < 2; ++n) acc[a][b][m][n] = (f32x4){0.f, 0.f, 0.f, 0.f};
        cur = nxt; cA = nA; cB = nB; ++ui;
        if constexpr (ALIGN_EPI) { if (wr == 1) PG8_BAR; }
    }
    PG8_WAIT_V(0);
    if constexpr (!ALIGN_EPI) { if (wr == 0) PG8_BAR; }
    PG8_BAR;
    if constexpr (Epi::AFTER_DRAIN) { E.fused(acc, cur, wr, wc, fr, fq, lds, wid, lane); S.done(cur); }
#undef PG8_SA
#undef PG8_SB
#undef PG8_STAGE
#undef PG8_LDA
#undef PG8_LDB
#undef PG8_MMA
#undef PG8_WAIT_V
#undef PG8_WAIT_L
#undef PG8_BAR
#undef PG8_SCHED
}
}
constexpr int NB = 4, SEQ = 8192, NMETA = 16, DM = 2048, MX = NB * SEQ  , META0 = MX  , MP = 33024  ;
constexpr int NCH = 129;
constexpr int PROJ_LD = 7168, NIN_P = 7424, DFF = 5632;
constexpr float EPS = 1e-6f;
constexpr size_t MiB = 1u << 20;
constexpr size_t WS_SMALL = 0;
constexpr size_t WS_GL    = 5 * MiB;
constexpr size_t WS_WIN   = 6 * MiB;
constexpr size_t WS_WOUT  = WS_WIN + 29 * MiB;
constexpr size_t WS_WGU   = WS_WOUT + 8 * MiB;
constexpr size_t WS_WDN   = WS_WGU + 44 * MiB;
constexpr size_t WS_NBUF  = WS_WDN + 22 * MiB;
constexpr size_t WS_PROJ  = WS_NBUF + 129 * MiB;
constexpr size_t WS_GDN   = WS_PROJ + 452 * MiB;
constexpr size_t WS_END   = WS_GDN + 319 * MiB;
constexpr int GDN_ITEM = 80896, GLA_ITEM = 82432;
constexpr int P3_BUF = 67072;
static_assert((size_t)MP * PROJ_LD * 2 <= 452 * MiB && (size_t)4128 * GDN_ITEM <= 319 * MiB && (size_t)2064 * GLA_ITEM <= (size_t)MX * DM * 4 && WS_END <= 1024 * MiB, "ws map");
constexpr int LDS_BYTES = 147456 + 64;

#define DI __device__ __forceinline__
typedef unsigned short bf16;
typedef float f32x4 __attribute__((ext_vector_type(4)));
typedef float f32x16 __attribute__((ext_vector_type(16)));
typedef short bf16x8 __attribute__((ext_vector_type(8)));
typedef unsigned short u16x4 __attribute__((ext_vector_type(4)));
typedef unsigned u32x4 __attribute__((ext_vector_type(4)));
typedef unsigned u32x2 __attribute__((ext_vector_type(2)));
typedef float f32x2_t __attribute__((ext_vector_type(2)));
typedef __bf16 bf16x2_t __attribute__((ext_vector_type(2)));
DI unsigned pk2(float lo, float hi) { f32x2_t v = {lo, hi}; bf16x2_t b = __builtin_convertvector(v, bf16x2_t); return __builtin_bit_cast(unsigned, b); }
DI bf16 f2bf(float f) { return (bf16)(pk2(f, 0.f) & 0xffffu); }
DI float bf2f(bf16 b) { return __uint_as_float((unsigned)b << 16); }
DI float bflo(unsigned w) { return __uint_as_float(w << 16); }
DI float bfhi(unsigned w) { return __uint_as_float(w & 0xffff0000u); }
#define MFMA32(a, b, c) __builtin_amdgcn_mfma_f32_32x32x16_bf16((a), (b), (c), 0, 0, 0)
DI int crow(int reg, int hh) { return (reg & 3) + 8 * (reg >> 2) + 4 * hh; }
DI int perm16(int k) { return 8 * ((k >> 2) & 1) + 4 * (k >> 3) + (k & 3); }
DI float wave_sum(float v) {
#pragma unroll
    for (int o = 1; o < 64; o <<= 1) v += __shfl_xor(v, o);
    return v;
}
DI float xor1(float v) { return __int_as_float(__builtin_amdgcn_update_dpp(0, __float_as_int(v), 0xB1, 0xF, 0xF, true)); }
DI int row_of(int b, int p) { return p < NMETA ? META0 + b * NMETA + p : b * SEQ + p - NMETA; }
DI float sigmoid_f(float x) { return __builtin_amdgcn_rcpf(1.0f + __expf(-x)); }
DI float silu_f(float x) { return x * sigmoid_f(x); }
#define LDS_WAIT() asm volatile("s_waitcnt lgkmcnt(0)" ::: "memory")

struct Args { const float* in[17]; float* out; unsigned char* ws; int ph_lo, ph_hi; };

DI int map_row(int mode, int n) {
    if (mode == 0) return n < 4096 ? n : (n < 4112 ? 7168 + (n - 4096) : (n < 7184 ? n - 16 : n));
    if (mode == 1) return (n >> 7) * 256 + (n & 127);
    if (mode == 2) return (n >> 7) * 256 + 128 + (n & 127);
    return n;
}
DI void transpose_load(const float* W, int N, int item, int lane, float (&tv)[32]) {
    const int nblk = N / 32, kb = item / nblk, nb = item % nblk, k0 = 64 * kb, n0 = 32 * nb;
#pragma unroll
    for (int i = 0; i < 32; ++i) { const int kk = 2 * i + (lane >> 5); tv[i] = W[(size_t)(k0 + kk) * N + n0 + (lane & 31)]; }
}
DI void transpose_store(const float (&tv)[32], int K, int N, bf16* WT, int mode, float* scr, int item, int lane, const float* kscale) {
    const int nblk = N / 32, kb = item / nblk, nb = item % nblk, k0 = 64 * kb, n0 = 32 * nb;
#pragma unroll
    for (int i = 0; i < 32; ++i) { const int kk = 2 * i + (lane >> 5); scr[kk * 33 + (lane & 31)] = tv[i]; }
    LDS_WAIT();
    const int c = lane & 7;
#pragma unroll
    for (int j = 0; j < 4; ++j) { const int n = (lane >> 3) + 8 * j; const float* s = scr + (8 * c) * 33 + n;
        f32x4 k0v = {1.f, 1.f, 1.f, 1.f}, k1v = {1.f, 1.f, 1.f, 1.f};
        if (mode == 1 || mode == 2) { k0v = *(const f32x4*)(kscale + k0 + 8 * c); k1v = *(const f32x4*)(kscale + k0 + 8 * c + 4); }
        u32x4 o; o.x = pk2(s[0 * 33] * k0v.x, s[1 * 33] * k0v.y); o.y = pk2(s[2 * 33] * k0v.z, s[3 * 33] * k0v.w); o.z = pk2(s[4 * 33] * k1v.x, s[5 * 33] * k1v.y); o.w = pk2(s[6 * 33] * k1v.z, s[7 * 33] * k1v.w);
        *(u32x4*)(WT + (size_t)map_row(mode, n0 + n) * K + k0 + 8 * c) = o; }
    LDS_WAIT();
}
DI void p0_item(const Args& a, int it, const float*& W, bf16*& WT, int& K, int& N, int& mode, int& item) {
    constexpr int I_IN = 32 * 225, I_OUT = 32 * 64, I_G = 32 * 176;
    unsigned char* ws = a.ws;
    const int sel = it < I_IN ? 0 : (it < I_IN + I_OUT ? 1 : (it < I_IN + I_OUT + I_G ? 2 : (it < I_IN + I_OUT + 2 * I_G ? 3 : 4)));
    item = it - (sel == 0 ? 0 : (sel == 1 ? I_IN : (sel == 2 ? I_IN + I_OUT : (sel == 3 ? I_IN + I_OUT + I_G : I_IN + I_OUT + 2 * I_G))));
    W = sel == 0 ? a.in[3] : (sel == 1 ? a.in[11] : (sel == 2 ? a.in[13] : (sel == 3 ? a.in[14] : a.in[15])));
    WT = (bf16*)(ws + (sel == 0 ? WS_WIN : (sel == 1 ? WS_WOUT : (sel == 4 ? WS_WDN : WS_WGU))));
    K = sel == 4 ? DFF : DM; N = sel == 0 ? 7200 : ((sel == 1 || sel == 4) ? DM : DFF); mode = sel == 0 ? 0 : (sel == 2 ? 1 : (sel == 3 ? 2 : 3));
}
DI void rms_row_bf16(const float* xrow, const float* w, bf16* orow, int lane) {
    const f32x4* xr = (const f32x4*)xrow + lane; const f32x4* wr = (const f32x4*)w + lane;
    f32x4 v[8], wv[8]; float s = 0.f;
#pragma unroll
    for (int j = 0; j < 8; ++j) v[j] = xr[64 * j];
#pragma unroll
    for (int j = 0; j < 8; ++j) wv[j] = wr[64 * j];
#pragma unroll
    for (int j = 0; j < 8; ++j) s += (v[j].x * v[j].x + v[j].y * v[j].y) + (v[j].z * v[j].z + v[j].w * v[j].w);
    const float rstd = rsqrtf(wave_sum(s) * (1.f / DM) + EPS);
    u32x2* o8 = (u32x2*)orow + lane;
#pragma unroll
    for (int j = 0; j < 8; ++j) { const f32x4 ww = wv[j]; u32x2 o; o.x = pk2(v[j].x * rstd * ww.x, v[j].y * rstd * ww.y); o.y = pk2(v[j].z * rstd * ww.z, v[j].w * rstd * ww.w); o8[64 * j] = o; }
}
DI void rms_row_f32(const float* xrow, const float* w, float* orow, int lane) {
    const f32x4* xr = (const f32x4*)xrow + lane; const f32x4* wr = (const f32x4*)w + lane;
    f32x4 v[8]; float s = 0.f;
#pragma unroll
    for (int j = 0; j < 8; ++j) { v[j] = xr[64 * j]; s += (v[j].x * v[j].x + v[j].y * v[j].y) + (v[j].z * v[j].z + v[j].w * v[j].w); }
    const float rstd = rsqrtf(wave_sum(s) * (1.f / DM) + EPS);
    f32x4* o = (f32x4*)orow + lane;
#pragma unroll
    for (int j = 0; j < 8; ++j) { const f32x4 ww = wr[64 * j]; o[64 * j] = v[j] * rstd * ww; }
}
DI void rms_rows2_bf16(const float* x0, const float* x1, const float* w, bf16* o0, bf16* o1, int lane) {
    const f32x4* xr0 = (const f32x4*)x0 + lane; const f32x4* xr1 = (const f32x4*)x1 + lane; const f32x4* wr = (const f32x4*)w + lane;
    f32x4 v0[8], v1[8], wv[8]; float s0 = 0.f, s1 = 0.f;
#pragma unroll
    for (int j = 0; j < 8; ++j) { v0[j] = xr0[64 * j]; v1[j] = xr1[64 * j]; }
#pragma unroll
    for (int j = 0; j < 8; ++j) wv[j] = wr[64 * j];
#pragma unroll
    for (int j = 0; j < 8; ++j) { s0 += (v0[j].x * v0[j].x + v0[j].y * v0[j].y) + (v0[j].z * v0[j].z + v0[j].w * v0[j].w); s1 += (v1[j].x * v1[j].x + v1[j].y * v1[j].y) + (v1[j].z * v1[j].z + v1[j].w * v1[j].w); }
    const float r0 = rsqrtf(wave_sum(s0) * (1.f / DM) + EPS), r1 = rsqrtf(wave_sum(s1) * (1.f / DM) + EPS);
    u32x2* p0 = (u32x2*)o0 + lane; u32x2* p1 = (u32x2*)o1 + lane;
#pragma unroll
    for (int j = 0; j < 8; ++j) { const f32x4 ww = wv[j]; u32x2 a, b;
        a.x = pk2(v0[j].x * r0 * ww.x, v0[j].y * r0 * ww.y); a.y = pk2(v0[j].z * r0 * ww.z, v0[j].w * r0 * ww.w);
        b.x = pk2(v1[j].x * r1 * ww.x, v1[j].y * r1 * ww.y); b.y = pk2(v1[j].z * r1 * ww.z, v1[j].w * r1 * ww.w);
        p0[64 * j] = a; p1[64 * j] = b; }
}
DI void rms_rows2_f32(const float* x0, const float* x1, const float* w, float* o0, float* o1, int lane) {
    const f32x4* xr0 = (const f32x4*)x0 + lane; const f32x4* xr1 = (const f32x4*)x1 + lane; const f32x4* wr = (const f32x4*)w + lane;
    f32x4 v0[8], v1[8], wv[8]; float s0 = 0.f, s1 = 0.f;
#pragma unroll
    for (int j = 0; j < 8; ++j) { v0[j] = xr0[64 * j]; v1[j] = xr1[64 * j]; }
#pragma unroll
    for (int j = 0; j < 8; ++j) wv[j] = wr[64 * j];
#pragma unroll
    for (int j = 0; j < 8; ++j) { s0 += (v0[j].x * v0[j].x + v0[j].y * v0[j].y) + (v0[j].z * v0[j].z + v0[j].w * v0[j].w); s1 += (v1[j].x * v1[j].x + v1[j].y * v1[j].y) + (v1[j].z * v1[j].z + v1[j].w * v1[j].w); }
    const float r0 = rsqrtf(wave_sum(s0) * (1.f / DM) + EPS), r1 = rsqrtf(wave_sum(s1) * (1.f / DM) + EPS);
    f32x4* p0 = (f32x4*)o0 + lane; f32x4* p1 = (f32x4*)o1 + lane;
#pragma unroll
    for (int j = 0; j < 8; ++j) { p0[64 * j] = v0[j] * r0 * wv[j]; p1[64 * j] = v1[j] * r1 * wv[j]; }
}
DI void rms_rows2_b2b(const bf16* x0, const bf16* x1, const float* w, bf16* o0, bf16* o1, int lane) {
    const u32x4* xr0 = (const u32x4*)x0 + lane; const u32x4* xr1 = (const u32x4*)x1 + lane;
    u32x4 v0[4], v1[4]; f32x4 wv[4][2]; float s0 = 0.f, s1 = 0.f;
#pragma unroll
    for (int j = 0; j < 4; ++j) { v0[j] = xr0[64 * j]; v1[j] = xr1[64 * j]; }
#pragma unroll
    for (int j = 0; j < 4; ++j) { const float* wp = w + 8 * lane + 512 * j; wv[j][0] = *(const f32x4*)wp; wv[j][1] = *(const f32x4*)(wp + 4); }
    float a0[4][8], a1[4][8];
#pragma unroll
    for (int j = 0; j < 4; ++j) {
        const unsigned p0[4] = {v0[j].x, v0[j].y, v0[j].z, v0[j].w}, p1[4] = {v1[j].x, v1[j].y, v1[j].z, v1[j].w};
#pragma unroll
        for (int e = 0; e < 4; ++e) { a0[j][2 * e] = bflo(p0[e]); a0[j][2 * e + 1] = bfhi(p0[e]); a1[j][2 * e] = bflo(p1[e]); a1[j][2 * e + 1] = bfhi(p1[e]); }
#pragma unroll
        for (int e = 0; e < 8; ++e) { s0 += a0[j][e] * a0[j][e]; s1 += a1[j][e] * a1[j][e]; } }
    const float r0 = rsqrtf(wave_sum(s0) * (1.f / DM) + EPS), r1 = rsqrtf(wave_sum(s1) * (1.f / DM) + EPS);
    u32x4* q0 = (u32x4*)o0 + lane; u32x4* q1 = (u32x4*)o1 + lane;
#pragma unroll
    for (int j = 0; j < 4; ++j) { const float ww[8] = {wv[j][0].x, wv[j][0].y, wv[j][0].z, wv[j][0].w, wv[j][1].x, wv[j][1].y, wv[j][1].z, wv[j][1].w};
        u32x4 oa, ob;
        oa.x = pk2(a0[j][0] * r0 * ww[0], a0[j][1] * r0 * ww[1]); oa.y = pk2(a0[j][2] * r0 * ww[2], a0[j][3] * r0 * ww[3]); oa.z = pk2(a0[j][4] * r0 * ww[4], a0[j][5] * r0 * ww[5]); oa.w = pk2(a0[j][6] * r0 * ww[6], a0[j][7] * r0 * ww[7]);
        ob.x = pk2(a1[j][0] * r1 * ww[0], a1[j][1] * r1 * ww[1]); ob.y = pk2(a1[j][2] * r1 * ww[2], a1[j][3] * r1 * ww[3]); ob.z = pk2(a1[j][4] * r1 * ww[4], a1[j][5] * r1 * ww[5]); ob.w = pk2(a1[j][6] * r1 * ww[6], a1[j][7] * r1 * ww[7]);
        q0[64 * j] = oa; q1[64 * j] = ob; }
}
DI void rms_rows2_b2f(const bf16* x0, const bf16* x1, const float* w, float* o0, float* o1, int lane) {
    const u32x4* xr0 = (const u32x4*)x0 + lane; const u32x4* xr1 = (const u32x4*)x1 + lane;
    u32x4 v0[4], v1[4]; f32x4 wv[4][2]; float s0 = 0.f, s1 = 0.f;
#pragma unroll
    for (int j = 0; j < 4; ++j) { v0[j] = xr0[64 * j]; v1[j] = xr1[64 * j]; }
#pragma unroll
    for (int j = 0; j < 4; ++j) { const float* wp = w + 8 * lane + 512 * j; wv[j][0] = *(const f32x4*)wp; wv[j][1] = *(const f32x4*)(wp + 4); }
    float a0[4][8], a1[4][8];
#pragma unroll
    for (int j = 0; j < 4; ++j) {
        const unsigned p0[4] = {v0[j].x, v0[j].y, v0[j].z, v0[j].w}, p1[4] = {v1[j].x, v1[j].y, v1[j].z, v1[j].w};
#pragma unroll
        for (int e = 0; e < 4; ++e) { a0[j][2 * e] = bflo(p0[e]); a0[j][2 * e + 1] = bfhi(p0[e]); a1[j][2 * e] = bflo(p1[e]); a1[j][2 * e + 1] = bfhi(p1[e]); }
#pragma unroll
        for (int e = 0; e < 8; ++e) { s0 += a0[j][e] * a0[j][e]; s1 += a1[j][e] * a1[j][e]; } }
    const float r0 = rsqrtf(wave_sum(s0) * (1.f / DM) + EPS), r1 = rsqrtf(wave_sum(s1) * (1.f / DM) + EPS);
#pragma unroll
    for (int j = 0; j < 4; ++j) { float* q0 = o0 + 8 * lane + 512 * j; float* q1 = o1 + 8 * lane + 512 * j;
        *(f32x4*)q0 = (f32x4){a0[j][0], a0[j][1], a0[j][2], a0[j][3]} * r0 * wv[j][0]; *(f32x4*)(q0 + 4) = (f32x4){a0[j][4], a0[j][5], a0[j][6], a0[j][7]} * r0 * wv[j][1];
        *(f32x4*)q1 = (f32x4){a1[j][0], a1[j][1], a1[j][2], a1[j][3]} * r1 * wv[j][0]; *(f32x4*)(q1 + 4) = (f32x4){a1[j][4], a1[j][5], a1[j][6], a1[j][7]} * r1 * wv[j][1]; }
}
DI void p0_prep(const Args& a, unsigned char* lds, int tid, int G) {
    const int lane = tid & 63, wave = tid >> 6, gw = blockIdx.x * 8 + wave, NGW = G * 8;
    float* scr = (float*)(lds + wave * 16384);
    unsigned char* ws = a.ws;
    bf16* win = (bf16*)(ws + WS_WIN); bf16* wout = (bf16*)(ws + WS_WOUT); bf16* wgu = (bf16*)(ws + WS_WGU); bf16* wdn = (bf16*)(ws + WS_WDN); bf16* nb = (bf16*)(ws + WS_NBUF);
    constexpr int I_IN = 32 * 225, I_OUT = 32 * 64, I_G = 32 * 176, I_D = 88 * 64, NITEMS = I_IN + I_OUT + 2 * I_G + I_D;
    for (int it = gw; it < NITEMS; it += 2 * NGW) {
        float tv0[32], tv1[32];
        const float* W0; bf16* T0; int K0, N0, m0, i0; const float* W1; bf16* T1; int K1, N1, m1, i1;
        const bool has1 = it + NGW < NITEMS;
        p0_item(a, it, W0, T0, K0, N0, m0, i0); p0_item(a, has1 ? it + NGW : it, W1, T1, K1, N1, m1, i1);
        transpose_load(W0, N0, i0, lane, tv0);
        if (has1) transpose_load(W1, N1, i1, lane, tv1);
        transpose_store(tv0, K0, N0, T0, m0, scr, i0, lane, a.in[12]);
        if (has1) transpose_store(tv1, K1, N1, T1, m1, scr, i1, lane, a.in[12]);
    }
    { const int gt = blockIdx.x * 512 + tid, GT = G * 512; const u32x4 z = {0u, 0u, 0u, 0u};
      u32x4* zw = (u32x4*)(win + (size_t)7200 * DM); for (int i = gt; i < 224 * 256; i += GT) zw[i] = z;
      u32x4* zn = (u32x4*)(nb + (size_t)(META0 + NB * NMETA) * DM); for (int i = gt; i < 192 * 256; i += GT) zn[i] = z; }
    for (int m = 2 * gw; m < MX + NB * NMETA; m += 2 * NGW) {
        const float* s0 = m < MX ? a.in[0] + (size_t)m * DM : a.in[1] + (size_t)((m - MX) & 15) * DM;
        const float* s1 = m < MX ? s0 + DM : a.in[1] + (size_t)((m + 1 - MX) & 15) * DM;
        rms_rows2_bf16(s0, s1, a.in[2], nb + (size_t)m * DM, nb + (size_t)(m + 1) * DM, lane);
    }
}

DI void p1_tail(const Args& a, unsigned char* lds, int tid, int bx, int G) {
    const int lane = tid & 63, wave = tid >> 6, r = lane & 31, hh = lane >> 5;
    const bf16* nbuf = (const bf16*)(a.ws + WS_NBUF); const bf16* win = (const bf16*)(a.ws + WS_WIN);
    bf16* proj = (bf16*)(a.ws + WS_PROJ); float* small = (float*)(a.ws + WS_SMALL);
    float* red = (float*)lds;
    for (int u = bx; u < 256; u += G) {
        f32x16 acc[4];
#pragma unroll
        for (int mt = 0; mt < 4; ++mt) for (int i = 0; i < 16; ++i) acc[mt][i] = 0.f;
        const bf16* bp = win + (size_t)(7168 + r) * DM + 256 * wave + 8 * hh; const bf16* ap = nbuf + (size_t)(128 * u + r) * DM + 256 * wave + 8 * hh;
#pragma unroll 4
        for (int s_ = 0; s_ < 16; ++s_) { const bf16x8 bf = *(const bf16x8*)(bp + 16 * s_);
#pragma unroll
            for (int mt = 0; mt < 4; ++mt) { const bf16x8 af = *(const bf16x8*)(ap + (size_t)(32 * mt) * DM + 16 * s_); acc[mt] = MFMA32(af, bf, acc[mt]); } }
#pragma unroll
        for (int mt = 0; mt < 4; ++mt)
#pragma unroll
            for (int i = 0; i < 16; ++i) red[wave * 4096 + (mt * 16 + i) * 64 + lane] = acc[mt][i];
        __syncthreads();
#pragma unroll
        for (int j = 0; j < 8; ++j) { const int o = tid + 512 * j; float sum = 0.f;
#pragma unroll
            for (int w = 0; w < 8; ++w) sum += red[w * 4096 + o];
            const int lo = o & 63, i = (o >> 6) & 15, mt = o >> 10; small[(size_t)(128 * u + 32 * mt + crow(i, lo >> 5)) * 32 + (lo & 31)] = sum; }
        __syncthreads();
    }
    for (int g = bx; g < 225; g += G) {
        f32x16 acc; for (int i = 0; i < 16; ++i) acc[i] = 0.f;
        const bf16* bp = win + (size_t)(32 * g + r) * DM + 256 * wave + 8 * hh; const bf16* ap = nbuf + (size_t)(META0 + (r & 15)) * DM + 256 * wave + 8 * hh;
#pragma unroll 4
        for (int s_ = 0; s_ < 16; ++s_) { const bf16x8 bf = *(const bf16x8*)(bp + 16 * s_); const bf16x8 af = *(const bf16x8*)(ap + 16 * s_); acc = MFMA32(af, bf, acc); }
#pragma unroll
        for (int i = 0; i < 16; ++i) red[wave * 1024 + i * 64 + lane] = acc[i];
        __syncthreads();
#pragma unroll
        for (int j = 0; j < 2; ++j) { const int o = tid + 512 * j; float sum = 0.f;
#pragma unroll
            for (int w = 0; w < 8; ++w) sum += red[w * 1024 + o];
            const int lo = o & 63, i = o >> 6, row16 = crow(i, lo >> 5), c = lo & 31;
            if (row16 < 16) {
#pragma unroll
                for (int b = 0; b < NB; ++b) { const size_t row = (size_t)(META0 + NMETA * b + row16);
                    if (g < 224) proj[row * PROJ_LD + 32 * g + c] = f2bf(sum); else small[row * 32 + c] = sum; } } }
        __syncthreads();
    }
}

#define SB() __builtin_amdgcn_sched_barrier(0)
#define LBAR_NOBAR() asm volatile("s_waitcnt lgkmcnt(0)" ::: "memory")
#define LBAR() do { asm volatile("s_waitcnt lgkmcnt(0)" ::: "memory"); __builtin_amdgcn_s_barrier(); asm volatile("" ::: "memory"); } while (0)
DI void gdn_stage_raw(const Args& a, unsigned char* lds, int item, int t, int nt) {
    const int h = item & 7, bc = item >> 3, c = bc % NCH, b = bc / NCH, p0 = c * 64 - 48;
    bf16* RAW = (bf16*)lds; const bf16* proj = (const bf16*)(a.ws + WS_PROJ);
    const int nit = (67 * 48 + nt - 1) / nt;
    for (int k0 = 0; k0 < nit; k0 += 7) {
        u32x4 v[7];
#pragma unroll
        for (int k = 0; k < 7; ++k) { const int idx = min(t + (k0 + k) * nt, 67 * 48 - 1); const int rr = idx / 48, ch = idx % 48, mat = ch >> 4, cc = ch & 15, p = p0 + rr - 3;
            v[k] = *(const u32x4*)(proj + (size_t)row_of(b, max(p, 0)) * PROJ_LD + mat * 1024 + h * 128 + cc * 8); if (p < 0) v[k] = (u32x4){0u, 0u, 0u, 0u}; }
#pragma unroll
        for (int k = 0; k < 7; ++k) { const int idx = t + (k0 + k) * nt; if (k0 + k < nit && idx < 67 * 48) { const int rr = idx / 48, ch = idx % 48; *(u32x4*)(RAW + rr * 392 + (ch >> 4) * 128 + (ch & 15) * 8) = v[k]; } }
    }
}
DI void gdn_gates(const Args& a, float* GCb, int item, int lane) {
    const int h = item & 7, bc = item >> 3, c = bc % NCH, b = bc / NCH, p = c * 64 - 48 + lane;
    const float* small = (const float*)(a.ws + WS_SMALL);
    float beta = 0.f, g = 0.f;
    { const float* sr = small + (size_t)row_of(b, max(p, 0)) * 32; const float av = sr[h], bv = sr[8 + h];
        beta = sigmoid_f(bv); const float xs = av + a.in[6][h]; const float sp = fmaxf(xs, 0.f) + log1pf(__expf(-fabsf(xs)));
        g = -__expf(a.in[5][h]) * sp; if (p < 0) { beta = 0.f; g = 0.f; } }
#pragma unroll
    for (int off = 1; off < 64; off <<= 1) { const float t = __shfl_up(g, off); if (lane >= off) g += t; }
    GCb[lane] = g; GCb[64 + lane] = beta;
}
DI void p2_gdn_item(const Args& a, unsigned char* lds, int item, int next, int par, int tid) {
    const int h = item & 7, bc = item >> 3, c = bc % NCH, b = bc / NCH;
    const int lane = tid & 63, wv = tid >> 6;
    bf16* RAW = (bf16*)lds;
    bf16* QB = (bf16*)(lds + 53248);
    bf16* KB = (bf16*)(lds + 53248 + 17408);
    float* AMD = (float*)(lds + 88064);
    bf16* RHS = (bf16*)(lds + 106496);
    float* GC = (float*)(lds + 140288) + 128 * par;
    float* BETA = GC + 64;
    unsigned char* it = a.ws + WS_GDN + (size_t)item * GDN_ITEM;
    bf16* o_w = (bf16*)it; bf16* o_qd = (bf16*)(it + 17408); bf16* o_kdT = (bf16*)(it + 34816); bf16* o_qk = (bf16*)(it + 53248); bf16* o_uT = (bf16*)(it + 62464);
    const int p0 = c * 64 - 48;
#ifndef REPS1
#define REPS1 1
#define REPS2 1
#define REPS3 1
#endif
    for (int rep_ = 0; rep_ < REPS1; ++rep_) {
        const int cgi = tid & 15, tq = tid >> 4, t0 = 2 * tq;
        const float* cw = (const float*)(lds + 141312);
#pragma unroll
        for (int mat = 0; mat < 3; ++mat) {
            f32x4 w4[4][2];
#pragma unroll
            for (int i = 0; i < 4; ++i) { const float* wp = cw + i * 384 + mat * 128 + cgi * 8; w4[i][0] = *(const f32x4*)wp; w4[i][1] = *(const f32x4*)(wp + 4); }
            float y[2][8];
#pragma unroll
            for (int tt = 0; tt < 2; ++tt)
#pragma unroll
                for (int e = 0; e < 8; ++e) y[tt][e] = 0.f;
#pragma unroll
            for (int rr = 0; rr < 5; ++rr) {
                const u32x4 rv = *(const u32x4*)(RAW + (t0 + rr) * 392 + mat * 128 + cgi * 8);
                float x[8] = {bflo(rv.x), bfhi(rv.x), bflo(rv.y), bfhi(rv.y), bflo(rv.z), bfhi(rv.z), bflo(rv.w), bfhi(rv.w)};
#pragma unroll
                for (int tt = 0; tt < 2; ++tt) { const int i = rr - tt; if (i >= 0 && i < 4) {
#pragma unroll
                    for (int e = 0; e < 8; ++e) y[tt][e] += w4[i][e >> 2][e & 3] * x[e]; } }
            }
#pragma unroll
            for (int tt = 0; tt < 2; ++tt) {
                const int t = t0 + tt; const bool valid = (p0 + t) >= 0;
                float s[8]; float ss = 0.f;
#pragma unroll
                for (int e = 0; e < 8; ++e) { s[e] = valid ? silu_f(y[tt][e]) : 0.f; ss += s[e] * s[e]; }
                const float gct = GC[t], eg = __expf(gct), bt = BETA[t];
                if (mat < 2) {
                    ss += __shfl_xor(ss, 1); ss += __shfl_xor(ss, 2); ss += __shfl_xor(ss, 4); ss += __shfl_xor(ss, 8);
                    const float rn = rsqrtf(ss + EPS) * (mat == 0 ? 0.08838834764831845f : 1.0f);
#pragma unroll
                    for (int e = 0; e < 8; ++e) s[e] *= rn;
                }
                u32x4 o; o.x = pk2(s[0], s[1]); o.y = pk2(s[2], s[3]); o.z = pk2(s[4], s[5]); o.w = pk2(s[6], s[7]);
                if (mat == 0) {
                    *(u32x4*)(QB + t * 136 + cgi * 8) = o;
                    u32x2 lo, hi; lo.x = pk2(s[0] * eg, s[1] * eg); lo.y = pk2(s[2] * eg, s[3] * eg); hi.x = pk2(s[4] * eg, s[5] * eg); hi.y = pk2(s[6] * eg, s[7] * eg);
                    int qoff = t * 136 + 16 * (cgi >> 1) + 4 * (cgi & 1); asm volatile("" : "+v"(qoff));
                    bf16* dst = o_qd + qoff;
                    *(u32x2*)dst = lo; *(u32x2*)(dst + 8) = hi;
                } else if (mat == 1) {
                    *(u32x4*)(KB + t * 136 + cgi * 8) = o;
                    const float f = bt * eg; u32x4 o2; o2.x = pk2(s[0] * f, s[1] * f); o2.y = pk2(s[2] * f, s[3] * f); o2.z = pk2(s[4] * f, s[5] * f); o2.w = pk2(s[6] * f, s[7] * f);
                    *(u32x4*)(RHS + t * 264 + 128 + cgi * 8) = o2;
                } else {
                    u32x4 o2; o2.x = pk2(s[0] * bt, s[1] * bt); o2.y = pk2(s[2] * bt, s[3] * bt); o2.z = pk2(s[4] * bt, s[5] * bt); o2.w = pk2(s[6] * bt, s[7] * bt);
                    *(u32x4*)(RHS + t * 264 + cgi * 8) = o2;
                }
            }
        }
    LBAR(); }
    for (int rep_ = 0; rep_ < REPS2; ++rep_) {
        const int which = wv >> 2, ti = (wv >> 1) & 1, tj = wv & 1, r = lane & 31, hh = lane >> 5;
        if (ti == 0 && tj == 1) {
            if (which == 0) {
                const int J = 32 + r;
#pragma unroll
                for (int i = 0; i < 16; ++i) AMD[(J & 1) * 2300 + crow(i, hh) * 36 + (J >> 1)] = 0.f;
            }
        } else {
            const bf16* Ab = (which ? QB : KB) + (32 * ti + r) * 136 + 8 * hh; const bf16* Bb = KB + (32 * tj + r) * 136 + 8 * hh;
            f32x16 acc; for (int i = 0; i < 16; ++i) acc[i] = 0.f;
#pragma unroll
            for (int ks = 0; ks < 8; ++ks) { const bf16x8 av = *(const bf16x8*)(Ab + 16 * ks); const bf16x8 bv = *(const bf16x8*)(Bb + 16 * ks); acc = MFMA32(av, bv, acc); }
            const int J = 32 * tj + r; const float gj = GC[J];
            int koff = (J & ~15) + perm16(J & 15); asm volatile("" : "+v"(koff));
#pragma unroll
            for (int i = 0; i < 16; ++i) {
                const int I = 32 * ti + crow(i, hh); const float gi = GC[I];
                if (which == 0) AMD[(J & 1) * 2300 + I * 36 + (J >> 1)] = (J < I) ? BETA[I] * acc[i] * __expf(gi - gj) : 0.f;
                else o_qk[I * 72 + koff] = f2bf((J <= I) ? acc[i] * __expf(gi - gj) : 0.f);
            }
        }
    LBAR(); }
    {
        const float gcl = GC[63];
        u32x4 nx[7]; int nh = 0, nb = 0, np0 = 0;
        if (next >= 0) { nh = next & 7; const int nbc = next >> 3; np0 = (nbc % NCH) * 64 - 48; nb = nbc / NCH;
#pragma unroll
            for (int k = 0; k < 7; ++k) { const int idx = min(tid + 512 * k, 67 * 48 - 1); const int rr = idx / 48, ch = idx % 48, mat = ch >> 4, cc = ch & 15, p = np0 + rr - 3;
                nx[k] = *(const u32x4*)((const bf16*)(a.ws + WS_PROJ) + (size_t)row_of(nb, max(p, 0)) * PROJ_LD + mat * 1024 + nh * 128 + cc * 8); if (p < 0) nx[k] = (u32x4){0u, 0u, 0u, 0u}; } }
#pragma unroll
        for (int q = 0; q < 2; ++q) {
            const int idx = tid + 512 * q, dk = idx >> 3, oct = idx & 7, G16 = oct >> 1, f = oct & 1;
            float v[8];
#pragma unroll
            for (int jj = 0; jj < 8; ++jj) { const int t = 16 * G16 + 8 * (jj >> 2) + 4 * f + (jj & 3); v[jj] = bf2f(KB[t * 136 + dk]) * __expf(gcl - GC[t]); }
            u32x4 o; o.x = pk2(v[0], v[1]); o.y = pk2(v[2], v[3]); o.z = pk2(v[4], v[5]); o.w = pk2(v[6], v[7]);
            *(u32x4*)(o_kdT + dk * 72 + 8 * oct) = o;
        }
        if (next >= 0) {
#pragma unroll
            for (int k = 0; k < 7; ++k) { const int idx = tid + 512 * k; if (idx < 67 * 48) { const int rr = idx / 48, ch = idx % 48; *(u32x4*)(RAW + rr * 392 + (ch >> 4) * 128 + (ch & 15) * 8) = nx[k]; } }
        }
        if (next >= 0 && wv == 7) gdn_gates(a, (float*)(lds + 140288) + 128 * (par ^ 1), next, lane);
        if (wv < 4) {
            const int cp = tid >> 1, hf = tid & 1;
            int zoff; asm volatile("v_mov_b32 %0, 0" : "=v"(zoff));
            const float* AMh = AMD + hf * 2300 + zoff;
            f32x2_t xh[32];
#pragma unroll
            for (int q = 0; q < 32; ++q) xh[q] = (f32x2_t){0.f, 0.f};
            { const unsigned r0 = *(const unsigned*)(RHS + 2 * cp); if (hf == 0) xh[0] = (f32x2_t){bflo(r0), bfhi(r0)}; }
#pragma unroll
            for (int ii = 0; ii < 31; ++ii) {
                const int i = 2 * ii + 1, j = i + 1;
                f32x4 Ai[8], Aj[8];
#pragma unroll
                for (int r4 = 0; r4 < (ii + 4) / 4; ++r4) { Ai[r4] = *(const f32x4*)(AMh + i * 36 + 4 * r4); Aj[r4] = *(const f32x4*)(AMh + j * 36 + 4 * r4); }
                const unsigned ri = *(const unsigned*)(RHS + i * 264 + 2 * cp), rj = *(const unsigned*)(RHS + j * 264 + 2 * cp);
                const float aji = AMD[2300 + j * 36 + ii + zoff];
                f32x2_t ai[2] = {{0.f, 0.f}, {0.f, 0.f}}, aj[2] = {{0.f, 0.f}, {0.f, 0.f}};
#pragma unroll
                for (int q = 0; q < ii + 1; ++q) { const float vi = Ai[q >> 2][q & 3], vj = Aj[q >> 2][q & 3]; ai[q & 1] += (f32x2_t){vi, vi} * xh[q]; aj[q & 1] += (f32x2_t){vj, vj} * xh[q]; }
                f32x2_t ti = ai[0] + ai[1], tj = aj[0] + aj[1];
                ti.x += xor1(ti.x); ti.y += xor1(ti.y); tj.x += xor1(tj.x); tj.y += xor1(tj.y);
                const f32x2_t xi = (f32x2_t){bflo(ri), bfhi(ri)} - ti;
                const f32x2_t xj = (f32x2_t){bflo(rj), bfhi(rj)} - tj - (f32x2_t){aji, aji} * xi;
                if (hf == 1) xh[ii] = xi; else xh[ii + 1] = xj;
            }
            {
                f32x4 Ac[8];
#pragma unroll
                for (int r4 = 0; r4 < 8; ++r4) Ac[r4] = *(const f32x4*)(AMh + 63 * 36 + 4 * r4);
                const unsigned rr = *(const unsigned*)(RHS + 63 * 264 + 2 * cp);
                f32x2_t acc[2] = {{0.f, 0.f}, {0.f, 0.f}};
#pragma unroll
                for (int q = 0; q < 32; ++q) { const float av = Ac[q >> 2][q & 3]; acc[q & 1] += (f32x2_t){av, av} * xh[q]; }
                f32x2_t tot = acc[0] + acc[1];
                tot.x += xor1(tot.x); tot.y += xor1(tot.y);
                const f32x2_t xi = (f32x2_t){bflo(rr), bfhi(rr)} - tot;
                if (hf == 1) xh[31] = xi;
            }
            f32x2_t ev[16], od[16];
#pragma unroll
            for (int q = 0; q < 16; ++q) { const f32x2_t send = hf ? xh[q] : xh[16 + q]; f32x2_t got; got.x = xor1(send.x); got.y = xor1(send.y); ev[q] = hf ? got : xh[q]; od[q] = hf ? xh[16 + q] : got; }
            if (wv < 2) {
                bf16* dst = o_uT + (2 * cp) * 72 + 32 * hf;
#pragma unroll
                for (int c4 = 0; c4 < 4; ++c4) { u32x4 o0, o1;
                    o0.x = pk2(ev[4 * c4].x, od[4 * c4].x); o0.y = pk2(ev[4 * c4 + 1].x, od[4 * c4 + 1].x); o0.z = pk2(ev[4 * c4 + 2].x, od[4 * c4 + 2].x); o0.w = pk2(ev[4 * c4 + 3].x, od[4 * c4 + 3].x);
                    o1.x = pk2(ev[4 * c4].y, od[4 * c4].y); o1.y = pk2(ev[4 * c4 + 1].y, od[4 * c4 + 1].y); o1.z = pk2(ev[4 * c4 + 2].y, od[4 * c4 + 2].y); o1.w = pk2(ev[4 * c4 + 3].y, od[4 * c4 + 3].y);
                    *(u32x4*)(dst + 8 * c4) = o0; *(u32x4*)(dst + 72 + 8 * c4) = o1; }
            } else {
                const int dk = 2 * cp - 128; unsigned* dst = (unsigned*)(QB + (dk & ~15) + perm16(dk & 15) + 32 * hf * 136);
#pragma unroll
                for (int q = 0; q < 16; ++q) { dst[(2 * q) * 68] = pk2(ev[q].x, ev[q].y); dst[(2 * q + 1) * 68] = pk2(od[q].x, od[q].y); }
            }
        }
        if (tid == 0) *(float*)((unsigned char*)QB + 256) = __expf(gcl);
        LBAR();
#pragma unroll
        for (int k = 0; k < 3; ++k) { const int idx = tid + 512 * k; if (idx < 1088) *(u32x4*)(it + 16 * idx) = *(const u32x4*)((const unsigned char*)QB + 16 * idx); }
        LBAR();
    }
}
DI void p2_gla_item(const Args& a, unsigned char* lds, int item, int tid) {
    const int h = item & 3, bc = item >> 2, c = bc % NCH, b = bc / NCH;
    const int lane = tid & 63, wv = tid >> 6;
    float* LR = (float*)lds;
    bf16* QB = (bf16*)(lds + 4096);
    bf16* KB = (bf16*)(lds + 4096 + 17408);
    bf16* VB = (bf16*)(lds + 4096 + 2 * 17408);
    float* PS = (float*)(lds + 4096 + 2 * 17408 + 33792);
    const bf16* proj = (const bf16*)(a.ws + WS_PROJ); const float* small = (const float*)(a.ws + WS_SMALL);
    unsigned char* it = (unsigned char*)a.out + (size_t)item * GLA_ITEM;
    bf16* o_qt = (bf16*)it; bf16* o_kdT = (bf16*)(it + 17408); bf16* o_sc = (bf16*)(it + 35840); float* o_dec = (float*)(it + 45056); bf16* o_vT = (bf16*)(it + 45568);
    const int p0 = c * 64 - 48;
    bf16 qraw[16], kraw[16];
    { const int d = tid & 127, tq = tid >> 7;
#pragma unroll
      for (int tt = 0; tt < 16; ++tt) { const int p = p0 + 16 * tq + tt; const bf16* rp = proj + (size_t)row_of(b, max(p, 0)) * PROJ_LD + h * 128 + d;
          qraw[tt] = rp[4096]; kraw[tt] = rp[4608]; if (p < 0) { qraw[tt] = 0; kraw[tt] = 0; } } }
    { float lrv[2]; u32x4 vv[4];
#pragma unroll
      for (int k = 0; k < 2; ++k) { const int idx = tid + 512 * k, t = idx >> 4, r = idx & 15, p = p0 + t; lrv[k] = small[(size_t)row_of(b, max(p, 0)) * 32 + 16 + r]; if (p < 0) lrv[k] = 0.f; }
#pragma unroll
      for (int k = 0; k < 4; ++k) { const int idx = tid + 512 * k, t = idx >> 5, cc = idx & 31, p = p0 + t; vv[k] = *(const u32x4*)(proj + (size_t)row_of(b, max(p, 0)) * PROJ_LD + 5120 + h * 256 + cc * 8); if (p < 0) vv[k] = (u32x4){0u, 0u, 0u, 0u}; }
#pragma unroll
      for (int k = 0; k < 2; ++k) LR[tid + 512 * k] = lrv[k];
#pragma unroll
      for (int k = 0; k < 4; ++k) { const int idx = tid + 512 * k; *(u32x4*)(VB + (idx >> 5) * 264 + (idx & 31) * 8) = vv[k]; } }
    LBAR();
    {
        const int d = tid & 127, tq = tid >> 7;
        float w2r[16];
#pragma unroll
        for (int r = 0; r < 16; ++r) w2r[r] = a.in[8][r * 512 + h * 128 + d];
        const float bias = a.in[9][h * 128 + d];
        float cs[16]; float run = 0.f;
#pragma unroll
        for (int tt = 0; tt < 16; ++tt) {
            const int t = 16 * tq + tt; float z = bias;
#pragma unroll
            for (int r4 = 0; r4 < 4; ++r4) { const f32x4 l4 = *(const f32x4*)(LR + t * 16 + 4 * r4); z += l4.x * w2r[4 * r4] + l4.y * w2r[4 * r4 + 1] + l4.z * w2r[4 * r4 + 2] + l4.w * w2r[4 * r4 + 3]; }
            const float ls = fminf(z, 0.f) - __logf(1.0f + __expf(-fabsf(z)));
            run += ((p0 + t) >= 0) ? ls * (1.f / 16.f) : 0.f; cs[tt] = run;
        }
        PS[tq * 128 + d] = run;
        LBAR();
        float off = 0.f, total = 0.f;
#pragma unroll
        for (int q = 0; q < 4; ++q) { const float v = PS[q * 128 + d]; total += v; if (q < tq) off += v; }
        float kd[16];
#pragma unroll
        for (int tt = 0; tt < 16; ++tt) {
            const int t = 16 * tq + tt; const float bc_ = off + cs[tt];
            const float qv = bf2f(qraw[tt]) * 0.08838834764831845f, kv = bf2f(kraw[tt]);
            const float qt = qv * __expf(bc_), kt = kv * __expf(-bc_); kd[tt] = kv * __expf(total - bc_);
            const bf16 qtb = f2bf(qt);
            QB[t * 136 + d] = qtb; KB[t * 136 + d] = f2bf(kt);
            o_qt[t * 136 + (d & ~15) + perm16(d & 15)] = qtb;
        }
        { bf16* dst = o_kdT + d * 72 + 16 * tq; u32x4 o0, o1;
          o0.x = pk2(kd[0], kd[1]); o0.y = pk2(kd[2], kd[3]); o0.z = pk2(kd[4], kd[5]); o0.w = pk2(kd[6], kd[7]);
          o1.x = pk2(kd[8], kd[9]); o1.y = pk2(kd[10], kd[11]); o1.z = pk2(kd[12], kd[13]); o1.w = pk2(kd[14], kd[15]);
          *(u32x4*)dst = o0; *(u32x4*)(dst + 8) = o1; }
        if (tq == 0) o_dec[d] = __expf(total);
#pragma unroll
        for (int q = 0; q < 4; ++q) { const int idx = tid + 512 * q, dv = idx >> 3, oct = idx & 7; bf16 v[8];
#pragma unroll
            for (int jj = 0; jj < 8; ++jj) v[jj] = VB[(8 * oct + jj) * 264 + dv];
            u32x4 o; o.x = v[0] | ((unsigned)v[1] << 16); o.y = v[2] | ((unsigned)v[3] << 16); o.z = v[4] | ((unsigned)v[5] << 16); o.w = v[6] | ((unsigned)v[7] << 16);
            *(u32x4*)(o_vT + dv * 72 + 8 * oct) = o; }
    }
    LBAR();
    if (wv < 3) {
        const int ti = wv == 0 ? 0 : 1, tj = wv == 2 ? 1 : 0, r = lane & 31, hh = lane >> 5;
        const bf16* Ab = QB + (32 * ti + r) * 136 + 8 * hh; const bf16* Bb = KB + (32 * tj + r) * 136 + 8 * hh;
        f32x16 acc; for (int i = 0; i < 16; ++i) acc[i] = 0.f;
#pragma unroll
        for (int ks = 0; ks < 8; ++ks) { const bf16x8 av = *(const bf16x8*)(Ab + 16 * ks); const bf16x8 bv = *(const bf16x8*)(Bb + 16 * ks); acc = MFMA32(av, bv, acc); }
        const int J = 32 * tj + r;
#pragma unroll
        for (int i = 0; i < 16; ++i) { const int I = 32 * ti + crow(i, hh); o_sc[I * 72 + J] = f2bf((J <= I) ? acc[i] : 0.f); }
    }
    LBAR();
}

DI bf16x8 pack8(const f32x16& x, int s) {
    u32x4 p; p.x = pk2(x[8 * s], x[8 * s + 1]); p.y = pk2(x[8 * s + 2], x[8 * s + 3]); p.z = pk2(x[8 * s + 4], x[8 * s + 5]); p.w = pk2(x[8 * s + 6], x[8 * s + 7]);
    return __builtin_bit_cast(bf16x8, p);
}
#define P3_BAR() do { asm volatile("s_waitcnt lgkmcnt(0)" ::: "memory"); __builtin_amdgcn_s_barrier(); asm volatile("" ::: "memory"); } while (0)
template <bool GDN> DI void p3_scan(const Args& a, unsigned char* lds, int bh, int sl, int tid) {
    constexpr int NSH = GDN ? 3904 : 2848, NTOT = NSH + 288, NPER = (NTOT + 447) / 448, ITEM = GDN ? GDN_ITEM : GLA_ITEM, SLOFF = GDN ? 62464 : 45568, NH = GDN ? 8 : 4;
    const int wave = __builtin_amdgcn_readfirstlane(tid >> 6), lane = tid & 63;
    const int b = bh / NH, h = bh % NH;
    const unsigned char* item0 = (GDN ? a.ws + WS_GDN : (const unsigned char*)a.out) + (size_t)((b * NCH) * NH + h) * ITEM;
    if (wave != 0) {
        const int pt = tid - 64;
        u32x4 R0[NPER], R1[NPER], R2[NPER], R3[NPER];
#define P3_ISSUE(R, c_) do { const unsigned char* src_ = item0 + (size_t)(c_) * NH * ITEM; _Pragma("unroll") for (int k = 0; k < NPER; ++k) { const int i = pt + 448 * k; \
            if (i < NTOT) R[k] = *(const u32x4*)(src_ + (i < NSH ? 16 * i : SLOFF + sl * 4608 + 16 * (i - NSH))); } } while (0)
#define P3_COMMIT(R, bi_) do { unsigned char* dst_ = lds + (bi_) * P3_BUF; _Pragma("unroll") for (int k = 0; k < NPER; ++k) { const int i = pt + 448 * k; if (i < NTOT) *(u32x4*)(dst_ + 16 * i) = R[k]; } } while (0)
        P3_ISSUE(R0, 0); P3_COMMIT(R0, 0); P3_ISSUE(R1, 1); P3_ISSUE(R2, 2); P3_ISSUE(R3, 3);
        P3_BAR();
        static_assert(NCH % 4 == 1, "producer loop: 32 groups of four chunks plus one tail chunk");
        for (int c = 0; c + 3 < NCH; c += 4) {
            if (c + 4 < NCH) P3_ISSUE(R0, c + 4);
            P3_COMMIT(R1, (c + 1) & 1);
            P3_BAR();
            if (c + 5 < NCH) P3_ISSUE(R1, c + 5);
            P3_COMMIT(R2, (c + 2) & 1);
            P3_BAR();
            if (c + 6 < NCH) P3_ISSUE(R2, c + 6);
            P3_COMMIT(R3, (c + 3) & 1);
            P3_BAR();
            if (c + 7 < NCH) P3_ISSUE(R3, c + 7);
            if (c + 4 < NCH) P3_COMMIT(R0, (c + 4) & 1);
            P3_BAR();
        }
        P3_BAR();
#undef P3_ISSUE
#undef P3_COMMIT
        return;
    }
    const int r = lane & 31, hh = lane >> 5;
    __builtin_amdgcn_s_setprio(3);
    bf16* O = (bf16*)(a.ws + WS_NBUF) + (GDN ? h * 128 : 1024 + h * 256) + 32 * sl + r;
    f32x16 S[4];
#pragma unroll
    for (int m = 0; m < 4; ++m) for (int i = 0; i < 16; ++i) S[m][i] = 0.f;
    P3_BAR();
    for (int c = 0; c < NCH; ++c) {
        const unsigned char* base = lds + (c & 1) * P3_BUF;
        bf16x8 Sp[4][2];
#pragma unroll
        for (int m = 0; m < 4; ++m) { Sp[m][0] = pack8(S[m], 0); Sp[m][1] = pack8(S[m], 1); }
        f32x16 QS[2];
        bf16x8 Vp[2][2];
        const unsigned char* qp = base + (GDN ? 17408 : 0) + r * 272 + 16 * hh; const unsigned char* sp = base + (GDN ? 53248 : 35840) + r * 144 + 16 * hh;
#define P3_QS1() do { _Pragma("unroll") for (int mt = 0; mt < 2; ++mt) { for (int i = 0; i < 16; ++i) QS[mt][i] = 0.f; \
            _Pragma("unroll") for (int m = 0; m < 4; ++m) _Pragma("unroll") for (int s = 0; s < 2; ++s) { const bf16x8 aq = *(const bf16x8*)(qp + mt * 32 * 272 + 32 * (2 * m + s)); QS[mt] = MFMA32(aq, Sp[m][s], QS[mt]); } } } while (0)
        if constexpr (GDN) {
            const unsigned char* wp = base + r * 272 + 16 * hh; const unsigned char* uT = base + 62464 + r * 144 + 8 * hh;
            f32x16 WS[2];
#pragma unroll
            for (int mt = 0; mt < 2; ++mt) { for (int i = 0; i < 16; ++i) WS[mt][i] = 0.f;
#pragma unroll
                for (int m = 0; m < 4; ++m)
#pragma unroll
                    for (int s = 0; s < 2; ++s) { const bf16x8 aw = *(const bf16x8*)(wp + mt * 32 * 272 + 32 * (2 * m + s)); WS[mt] = MFMA32(aw, Sp[m][s], WS[mt]); } }
            P3_QS1();
#pragma unroll
            for (int mt = 0; mt < 2; ++mt) { f32x16 vn;
#pragma unroll
                for (int g = 0; g < 4; ++g) { const u32x2 u4 = *(const u32x2*)(uT + 2 * (32 * mt + 8 * g));
                    vn[4 * g] = bflo(u4.x) - WS[mt][4 * g]; vn[4 * g + 1] = bfhi(u4.x) - WS[mt][4 * g + 1]; vn[4 * g + 2] = bflo(u4.y) - WS[mt][4 * g + 2]; vn[4 * g + 3] = bfhi(u4.y) - WS[mt][4 * g + 3]; }
                Vp[mt][0] = pack8(vn, 0); Vp[mt][1] = pack8(vn, 1); }
        } else {
            const unsigned char* vT = base + 45568 + r * 144 + 16 * hh;
#pragma unroll
            for (int mt2 = 0; mt2 < 2; ++mt2)
#pragma unroll
                for (int s = 0; s < 2; ++s) Vp[mt2][s] = *(const bf16x8*)(vT + 32 * (2 * mt2 + s));
            P3_QS1();
        }
#undef P3_QS1
        SB();
        {
            const unsigned char* kp = base + (GDN ? 34816 : 17408) + r * 144 + 16 * hh;
            float gl = 1.f; if constexpr (GDN) gl = *(const float*)(base + 256);
#pragma unroll
            for (int m = 0; m < 4; ++m) {
                if constexpr (GDN) S[m] = S[m] * gl;
                else {
#pragma unroll
                    for (int g = 0; g < 4; ++g) { const f32x4 d4 = *(const f32x4*)(base + 45056 + 4 * (32 * m + 8 * g + 4 * hh)); S[m][4 * g] *= d4.x; S[m][4 * g + 1] *= d4.y; S[m][4 * g + 2] *= d4.z; S[m][4 * g + 3] *= d4.w; } }
#pragma unroll
                for (int mt2 = 0; mt2 < 2; ++mt2)
#pragma unroll
                    for (int s = 0; s < 2; ++s) { const bf16x8 aa = *(const bf16x8*)(kp + m * 32 * 144 + 32 * (2 * mt2 + s)); S[m] = MFMA32(aa, Vp[mt2][s], S[m]); } }
#pragma unroll
            for (int mt = 0; mt < 2; ++mt)
#pragma unroll
                for (int mt2 = 0; mt2 <= mt; ++mt2)
#pragma unroll
                    for (int s = 0; s < 2; ++s) { const bf16x8 aa = *(const bf16x8*)(sp + mt * 32 * 144 + 32 * (2 * mt2 + s)); QS[mt] = MFMA32(aa, Vp[mt2][s], QS[mt]); }
        }
        if (c > 0) {
            bf16* orow = O + (size_t)(b * SEQ + (c - 1) * 64) * DM;
#pragma unroll
            for (int mt = 0; mt < 2; ++mt)
#pragma unroll
                for (int i = 0; i < 16; ++i) orow[(size_t)(32 * mt + crow(i, hh)) * DM] = f2bf(QS[mt][i]);
        }
        P3_BAR();
    }
    __builtin_amdgcn_s_setprio(0);
}

#define DPPF(v, ctrl) __int_as_float(__builtin_amdgcn_update_dpp(0, __float_as_int(v), (ctrl), 0xF, 0xF, true))
DI float sum16(float v) {
    v += DPPF(v, 0xB1); v += DPPF(v, 0x4E); v += DPPF(v, 0x141); v += DPPF(v, 0x140); return v;
}
DI void p4_rows2(const Args& a, int row, int lane) {
    bf16* O = (bf16*)(a.ws + WS_NBUF) + (size_t)row * DM; const bf16* pr = (const bf16*)(a.ws + WS_PROJ) + (size_t)row * PROJ_LD;
    u32x4 ov[2][4], gv[2][4]; f32x4 wv[4][2];
#pragma unroll
    for (int rr = 0; rr < 2; ++rr)
#pragma unroll
        for (int j = 0; j < 4; ++j) { const int col = 8 * lane + 512 * j;
            ov[rr][j] = *(const u32x4*)(O + (size_t)rr * DM + col);
            gv[rr][j] = *(const u32x4*)(pr + (size_t)rr * PROJ_LD + (j < 2 ? 3072 + col : 6144 + (col - 1024))); }
#pragma unroll
    for (int j = 0; j < 4; ++j) { const int col = 8 * lane + 512 * j; const float* nw = j < 2 ? a.in[7] + (col & 127) : a.in[10] + ((col - 1024) & 255);
        wv[j][0] = *(const f32x4*)nw; wv[j][1] = *(const f32x4*)(nw + 4); }
#pragma unroll
    for (int rr = 0; rr < 2; ++rr)
#pragma unroll
        for (int j = 0; j < 4; ++j) {
            const int col = 8 * lane + 512 * j; const u32x4 o4 = ov[rr][j], g4 = gv[rr][j];
            float o[8] = {bflo(o4.x), bfhi(o4.x), bflo(o4.y), bfhi(o4.y), bflo(o4.z), bfhi(o4.z), bflo(o4.w), bfhi(o4.w)};
            float g[8] = {bflo(g4.x), bfhi(g4.x), bflo(g4.y), bfhi(g4.y), bflo(g4.z), bfhi(g4.z), bflo(g4.w), bfhi(g4.w)};
            float w[8] = {wv[j][0].x, wv[j][0].y, wv[j][0].z, wv[j][0].w, wv[j][1].x, wv[j][1].y, wv[j][1].z, wv[j][1].w};
            float ss = 0.f;
#pragma unroll
            for (int e = 0; e < 8; ++e) ss += o[e] * o[e];
            ss = sum16(ss);
            float rn;
            if (j < 2) rn = rsqrtf(ss * (1.f / 128.f) + EPS);
            else { ss += __shfl_xor(ss, 16); rn = rsqrtf(ss * (1.f / 256.f) + EPS); }
            float y[8];
#pragma unroll
            for (int e = 0; e < 8; ++e) y[e] = o[e] * rn * w[e] * silu_f(g[e]);
            u32x4 res; res.x = pk2(y[0], y[1]); res.y = pk2(y[2], y[3]); res.z = pk2(y[4], y[5]); res.w = pk2(y[6], y[7]);
            *(u32x4*)(O + (size_t)rr * DM + col) = res;
        }
}

#define LAS __attribute__((address_space(3)))
#define XB_TMO      128
#define XB_XCNT(j)  (256  + 64 * (j))
#define XB_XSUB(j)  (1280 + 64 * (j))
#define XB_XGEN(j)  (2304 + 64 * (j))
#define XB_TOP      3328
#define XB_TOPGEN   3392
#define XCD_BAR_WORDS 3456
#define XB_SPIN_CAP (1u << 18)

__device__ __forceinline__ unsigned xb_ld(unsigned* p)              { return __hip_atomic_load(p, __ATOMIC_RELAXED, __HIP_MEMORY_SCOPE_AGENT); }
__device__ __forceinline__ unsigned xb_add(unsigned* p, unsigned v) { return __hip_atomic_fetch_add(p, v, __ATOMIC_RELAXED, __HIP_MEMORY_SCOPE_AGENT); }
__device__ __forceinline__ unsigned xb_xcc_id() { return (unsigned)__builtin_amdgcn_s_getreg((3 << 11) | 20) & 0xFu; }
#define XB_SPIN(cond, bar) do { unsigned _sp = 0; while (cond) { __builtin_amdgcn_s_sleep(1); \
    if ((++_sp & 255u) == 0u) { if (xb_ld(&(bar)[XB_TMO])) break; if (_sp > XB_SPIN_CAP) { atomicAdd(&(bar)[XB_TMO], 1u); break; } } } } while (0)

struct XcdBarrier {
    unsigned* bar; unsigned x;
    volatile LAS unsigned* st;
};

__device__ __forceinline__ XcdBarrier xcd_barrier_post(unsigned* bar, volatile LAS unsigned* st) {
    XcdBarrier b; b.bar = bar; b.x = xb_xcc_id(); b.st = st;
    if (threadIdx.x == 0) (void)xb_add(&bar[XB_XCNT(b.x)], 1u);
    return b;
}
__device__ __forceinline__ void xcd_barrier_complete(unsigned* bar, unsigned x, unsigned& nloc, unsigned& nx) {
    const unsigned G = gridDim.x * gridDim.y * gridDim.z;
    unsigned sum, cnt, mine, sp = 0u;
    for (;;) {
        sum = 0u; cnt = 0u; mine = 0u;
#pragma unroll
        for (unsigned j = 0; j < 16; ++j) { const unsigned c = xb_ld(&bar[XB_XCNT(j)]); sum += c; cnt += (c > 0u) ? 1u : 0u; mine = (j == x) ? c : mine; }
        if (sum == G) break;
        __builtin_amdgcn_s_sleep(1);
        if ((++sp & 255u) == 0u) { if (xb_ld(&bar[XB_TMO])) break; if (sp > XB_SPIN_CAP) { atomicAdd(&bar[XB_TMO], 1u); break; } }
    }
    nloc = mine > 0u ? mine : 1u; nx = cnt > 0u ? cnt : 1u;
}

__device__ __forceinline__ void xcd_barrier(const XcdBarrier& b) {
    asm volatile("s_waitcnt vmcnt(0)" ::: "memory");
    __syncthreads();
    if (threadIdx.x == 0) {
        unsigned* bar = b.bar;
        __builtin_amdgcn_s_waitcnt(0);
        unsigned nloc = b.st[0], nx = b.st[1];
        if (nloc == 0u) { xcd_barrier_complete(bar, b.x, nloc, nx); b.st[0] = nloc; b.st[1] = nx; }
        const unsigned old = xb_add(&bar[XB_XSUB(b.x)], 1u);
        const unsigned gen = old / nloc;
        if (old + 1u == (gen + 1u) * nloc) {
            __builtin_amdgcn_fence(__ATOMIC_RELEASE, "agent");
            asm volatile("s_waitcnt vmcnt(0)" ::: "memory");
            const unsigned og = xb_add(&bar[XB_TOP], 1u);
            const unsigned tg = og / nx;
            if (og + 1u == (tg + 1u) * nx) xb_add(&bar[XB_TOPGEN], 1u);
            else XB_SPIN(xb_ld(&bar[XB_TOPGEN]) == tg, bar);
            __builtin_amdgcn_fence(__ATOMIC_ACQUIRE, "agent");
            xb_add(&bar[XB_XGEN(b.x)], 1u);
            asm volatile("s_waitcnt vmcnt(0)" ::: "memory");
        } else {
            XB_SPIN(xb_ld(&bar[XB_XGEN(b.x)]) == gen, bar);
            __builtin_amdgcn_fence(__ATOMIC_ACQUIRE, "agent");
            asm volatile("s_waitcnt vmcnt(0)" ::: "memory");
        }
    }
    __syncthreads();
}

__global__ void __launch_bounds__(512, 2) mk_fwd(Args a) {
    extern __shared__ __attribute__((aligned(16))) unsigned char lds[];
    cg::grid_group grid = cg::this_grid();
    const int tid = threadIdx.x, lane = tid & 63, wave = __builtin_amdgcn_readfirstlane(tid >> 6), G = gridDim.x, bx = blockIdx.x;
    const int gw = bx * 8 + wave, NGW = G * 8;
    unsigned char* ws = a.ws;
    PG8_LAS unsigned char* ring = (PG8_LAS unsigned char*)lds;
    const int lo = a.ph_lo, hi = a.ph_hi;
#ifndef SKIPMASK
#define SKIPMASK 0
#endif
#define IN(k) (!((SKIPMASK >> (k)) & 1) && lo <= (k) && (k) < hi)
#ifndef REP2
#define REP2 1
#endif
#ifndef REP3
#define REP3 1
#endif
#ifndef REP7
#define REP7 1
#endif
#define SEAM(k) do { if (IN(k) && IN((k) + 1)) xcd_barrier(bar); } while (0)
#ifdef XSYNC
    for (int q_ = 0; q_ < XSYNC; ++q_) grid.sync();
#endif
#ifdef REP0
    if (IN(0)) p0_prep(a, lds, tid, G);
    __syncthreads();
#endif
    volatile LAS unsigned* bst = (volatile LAS unsigned*)((LAS unsigned char*)lds + 147456);
    if (tid == 0) { bst[0] = 0u; bst[1] = 0u; }
    __syncthreads();
    if (IN(0)) p0_prep(a, lds, tid, G);
    if (bx == 0) { unsigned* bw = (unsigned*)(ws + WS_GL); for (int i = tid; i < XCD_BAR_WORDS; i += 512) bw[i] = 0u; }
    grid.sync();
    XcdBarrier bar = xcd_barrier_post((unsigned*)(ws + WS_GL), bst);
    if (IN(1)) {
        pg8::Gemm g{(const pg8::bf16_t*)(ws + WS_NBUF), (const pg8::bf16_t*)(ws + WS_WIN), MX, PROJ_LD, DM}; pg8::StaticOrder S; S.init(MX, PROJ_LD, G, bx);
        pg8::EpiProj E{(pg8::bf16_t*)(ws + WS_PROJ), (float*)(ws + WS_SMALL)};
        pg8::gemm_phase<pg8::EpiProj, pg8::StaticOrder, true, true>(ring, g, S, E);
        p1_tail(a, lds, tid, bx, G);
    }
    SEAM(1);
    if (IN(2)) {
        { const int h0 = bx & 7; float* cwl = (float*)(lds + 141312); for (int i = tid; i < 4 * 384; i += 512) { const int tap = i / 384, ch = i % 384; cwl[i] = a.in[4][tap * 3072 + (ch >> 7) * 1024 + h0 * 128 + (ch & 127)]; } }
        if (bx < 4128) { gdn_stage_raw(a, lds, bx, tid, 512); if (wave == 0) gdn_gates(a, (float*)(lds + 140288), bx, lane); }
        LBAR();
        { int par = 0; for (int it = bx; it < 4128; it += G, par ^= 1) {
            if ((G & 7) && it != bx) { LBAR(); const int h0 = it & 7; float* cwl = (float*)(lds + 141312); for (int i = tid; i < 4 * 384; i += 512) { const int tap = i / 384, ch = i % 384; cwl[i] = a.in[4][tap * 3072 + (ch >> 7) * 1024 + h0 * 128 + (ch & 127)]; } LBAR(); }
            p2_gdn_item(a, lds, it, it + G < 4128 ? it + G : -1, par, tid); } }
        for (int it = G - 1 - bx; it < 2064; it += G) p2_gla_item(a, lds, it, tid);
#ifdef REPGLA
        for (int it = G - 1 - bx; it < 2064; it += G) p2_gla_item(a, lds, it, tid);
#endif
    }
#if REP2 > 1
    __syncthreads();
    if (IN(2)) {
        { const int h0 = bx & 7; float* cwl = (float*)(lds + 141312); for (int i = tid; i < 4 * 384; i += 512) { const int tap = i / 384, ch = i % 384; cwl[i] = a.in[4][tap * 3072 + (ch >> 7) * 1024 + h0 * 128 + (ch & 127)]; } }
        if (bx < 4128) { gdn_stage_raw(a, lds, bx, tid, 512); if (wave == 0) gdn_gates(a, (float*)(lds + 140288), bx, lane); }
        LBAR();
        { int par = 0; for (int it = bx; it < 4128; it += G, par ^= 1) {
            if ((G & 7) && it != bx) { LBAR(); const int h0 = it & 7; float* cwl = (float*)(lds + 141312); for (int i = tid; i < 4 * 384; i += 512) { const int tap = i / 384, ch = i % 384; cwl[i] = a.in[4][tap * 3072 + (ch >> 7) * 1024 + h0 * 128 + (ch & 127)]; } LBAR(); }
            p2_gdn_item(a, lds, it, it + G < 4128 ? it + G : -1, par, tid); } }
        for (int it = G - 1 - bx; it < 2064; it += G) p2_gla_item(a, lds, it, tid);
    }
#endif
    SEAM(2);
    if (IN(3)) {
        for (int u = bx; u < 256; u += G) {
            const int x = u & 7, j = u >> 3;
            if (j < 16) p3_scan<true>(a, lds, 4 * x + (j >> 2), j & 3, tid);
            else p3_scan<false>(a, lds, 2 * x + ((j - 16) >> 3), (j - 16) & 7, tid);
            __syncthreads();
        }
    }
#if REP3 > 1
    __syncthreads();
    if (IN(3)) {
        for (int u = bx; u < 256; u += G) {
            const int x = u & 7, j = u >> 3;
            if (j < 16) p3_scan<true>(a, lds, 4 * x + (j >> 2), j & 3, tid);
            else p3_scan<false>(a, lds, 2 * x + ((j - 16) >> 3), (j - 16) & 7, tid);
            __syncthreads();
        }
    }
#endif
    SEAM(3);
    if (IN(4)) for (int row = 2 * gw; row < MX; row += 2 * NGW) p4_rows2(a, row, lane);
    SEAM(4);
    if (IN(5)) {
        pg8::Gemm g{(const pg8::bf16_t*)(ws + WS_NBUF), (const pg8::bf16_t*)(ws + WS_WOUT), MX, DM, DM}; pg8::StaticOrder S; S.init(MX, DM, G, bx);
        pg8::EpiResF2B E{a.in[0], (pg8::bf16_t*)(ws + WS_GDN), (float*)(ws + WS_SMALL)};
        pg8::gemm_phase<pg8::EpiResF2B, pg8::StaticOrder, true, true>(ring, g, S, E);
    }
    SEAM(5);
    if (IN(6)) for (int row = bx * 512 + tid; row < MX; row += G * 512) {
        const f32x4* pp = (const f32x4*)(ws + WS_SMALL) + (size_t)row * 8; float t = 0.f;
#pragma unroll
        for (int j = 0; j < 8; ++j) { const f32x4 v = pp[j]; t += (v.x + v.y) + (v.z + v.w); }
        ((float*)(ws + WS_GL + 65536))[row] = rsqrtf(t * (1.f / DM) + EPS);
    }
    SEAM(6);
    if (IN(7)) {
        pg8::Gemm g{(const pg8::bf16_t*)(ws + WS_GDN), (const pg8::bf16_t*)(ws + WS_WGU), MX, 2 * DFF, DM}; pg8::StaticOrder S; S.init(MX, 2 * DFF, G, bx);
        pg8::EpiSwiGLUr E{(pg8::bf16_t*)(ws + WS_PROJ), (const float*)(ws + WS_GL + 65536)};
        pg8::gemm_phase<pg8::EpiSwiGLUr, pg8::StaticOrder, true, true>(ring, g, S, E);
    }
#if REP7 > 1
    __syncthreads();
    if (IN(7)) {
        pg8::Gemm g{(const pg8::bf16_t*)(ws + WS_GDN), (const pg8::bf16_t*)(ws + WS_WGU), MX, 2 * DFF, DM}; pg8::StaticOrder S; S.init(MX, 2 * DFF, G, bx);
        pg8::EpiSwiGLUr E{(pg8::bf16_t*)(ws + WS_PROJ), (const float*)(ws + WS_GL + 65536)};
        pg8::gemm_phase<pg8::EpiSwiGLUr, pg8::StaticOrder, true, true>(ring, g, S, E);
    }
#endif
    SEAM(7);
    if (IN(8)) {
        pg8::Gemm g{(const pg8::bf16_t*)(ws + WS_PROJ), (const pg8::bf16_t*)(ws + WS_WDN), MX, DM, DFF}; pg8::StaticOrder S; S.init(MX, DM, G, bx);
        pg8::EpiResB2B E{(const pg8::bf16_t*)(ws + WS_GDN), (pg8::bf16_t*)(ws + WS_NBUF)};
        pg8::gemm_phase<pg8::EpiResB2B, pg8::StaticOrder, true, true>(ring, g, S, E);
    }
    SEAM(8);
    if (IN(9)) for (int row = 2 * gw; row < MX; row += 2 * NGW) rms_rows2_b2f((const bf16*)(ws + WS_NBUF) + (size_t)row * DM, (const bf16*)(ws + WS_NBUF) + (size_t)(row + 1) * DM, a.in[16], a.out + (size_t)row * DM, a.out + (size_t)(row + 1) * DM, lane);
#undef IN
#undef SEAM
}

extern "C" void kernel_launch(void* const* d_in, const int* in_sizes, int n_in, void* d_out, int out_size, void* d_ws, size_t ws_size, hipStream_t stream) {
    static int grid = 0;
    if (grid == 0) {
        int dev = 0, cus = 0, per_cu = 0;
        if (n_in != 17 || out_size != MX * DM || ws_size < WS_END) { fprintf(stderr, "kernel_launch: unexpected shapes (n_in %d out %d ws %zu)\n", n_in, out_size, ws_size); grid = -1; return; }
        (void)hipGetDevice(&dev);
        (void)hipDeviceGetAttribute(&cus, hipDeviceAttributeMultiprocessorCount, dev);
        (void)hipFuncSetAttribute((const void*)mk_fwd, hipFuncAttributeMaxDynamicSharedMemorySize, LDS_BYTES);
        (void)hipOccupancyMaxActiveBlocksPerMultiprocessor(&per_cu, (const void*)mk_fwd, 512, LDS_BYTES);
        if (per_cu < 1) per_cu = 1;
        grid = cus * per_cu;
    }
    if (grid < 0) return;
    Args a{};
    for (int i = 0; i < 17; ++i) a.in[i] = (const float*)d_in[i];
    a.out = (float*)d_out; a.ws = (unsigned char*)d_ws; a.ph_lo = 0; a.ph_hi = 10;
    void* args[] = {&a};
    hipError_t e = hipLaunchCooperativeKernel((const void*)mk_fwd, dim3(grid), dim3(512), args, LDS_BYTES, stream);
    if (e != hipSuccess) fprintf(stderr, "cooperative launch failed: %s (grid %d)\n", hipGetErrorString(e), grid);
}
```

```cpp
#include <hip/hip_runtime.h>
#include <hip/hip_cooperative_groups.h>
#include <cstdio>
#include <cstdint>
namespace cg = cooperative_groups;
namespace pg8 {
#define PG8_LAS __attribute__((address_space(3)))
typedef unsigned short bf16_t;
typedef short bf16x8 __attribute__((ext_vector_type(8)));
typedef float f32x4 __attribute__((ext_vector_type(4)));
typedef unsigned u32x4 __attribute__((ext_vector_type(4)));
constexpr int BM = 256, BK = 64, HALF = 128, HTB = HALF * BK * 2  , STAGE_BYTES = 8 * HTB, NXCD = 8, WGM = 8;

__host__ __device__ __forceinline__ int lds_byte(int r, int c) { const int st = (r >> 4) * 2 + (c >> 5), rr = r & 15, cc = c & 31, ob = rr * 64 + cc * 2; return st * 1024 + (ob ^ (((ob >> 9) & 1) << 5)); }
__host__ __device__ __forceinline__ void stage_rc(int b, int& R, int& C) { const int st = b / 1024, sb = b % 1024, swz = sb ^ (((sb >> 9) & 1) << 5); R = (st >> 1) * 16 + swz / 64; C = (st & 1) * 32 + (swz % 64) / 2; }
__host__ __device__ __forceinline__ int perm32(int rho) { const int n = rho >> 4, i = rho & 15; return 8 * (i >> 2) + 4 * n + (i & 3); }

struct Unit { int pm, pn; };
struct Gemm { const bf16_t* A; const bf16_t* Bt; int M, N, K; };

struct StaticOrder {
    int nM, nN, nwg, G, c;
    __host__ __device__ void init(int M, int N, int G_, int c_) { nM = M / BM; nN = N / BM; nwg = nM * nN; G = G_; c = c_; }
    __host__ __device__ bool next(int i, Unit& u) const {
        const long L = (long)i * G + c; if (L >= nwg) return false;
        int wgid = (int)L; { const int q = nwg / NXCD, r = nwg % NXCD, xcd = wgid % NXCD, off = wgid / NXCD; wgid = (xcd < r ? xcd * (q + 1) : r * (q + 1) + (xcd - r) * q) + off; }
        const int nig = WGM * nN, gid = wgid / nig, fm = gid * WGM, gsz = (nM - fm) < WGM ? (nM - fm) : WGM;
        u.pm = fm + ((wgid % nig) % gsz); u.pn = (wgid % nig) / gsz; return true;
    }
    __device__ __forceinline__ void a_ready(const Unit&) const {}
    __device__ __forceinline__ void done(const Unit&) const {}
};

__device__ __forceinline__ unsigned cvt_pk_bf16(float lo, float hi) { unsigned r; asm volatile("v_cvt_pk_bf16_f32 %0, %1, %2" : "=v"(r) : "v"(lo), "v"(hi)); return r; }
typedef float f32x2 __attribute__((ext_vector_type(2)));
__device__ __forceinline__ float silu_f(float g) { return g * __builtin_amdgcn_rcpf(1.0f + __expf(-g)); }
struct EpiProj {
    static constexpr bool PERM = true, AFTER_DRAIN = false;
    bf16_t* O; float* Sm;
    __device__ __forceinline__ void operator()(const f32x4 (&acc)[2][2][4][2], const Unit& u, int wr, int wc, int fr, int fq) const {
        const int row0 = u.pm * BM + wr * 64 + fr;
        if (u.pn < 28) {
            const int col0 = u.pn * BM + wc * 32 + 8 * fq;
#pragma unroll
            for (int ai = 0; ai < 2; ++ai)
#pragma unroll
                for (int m = 0; m < 4; ++m) { bf16_t* rowp = O + (size_t)(row0 + ai * HALF + m * 16) * 7168 + col0;
#pragma unroll
                    for (int bj = 0; bj < 2; ++bj) { const f32x4 v0 = acc[ai][bj][m][0], v1 = acc[ai][bj][m][1];
                        u32x4 w; w.x = cvt_pk_bf16(v0[0], v0[1]); w.y = cvt_pk_bf16(v0[2], v0[3]); w.z = cvt_pk_bf16(v1[0], v1[1]); w.w = cvt_pk_bf16(v1[2], v1[3]);
                        *(u32x4*)(rowp + bj * HALF) = w; } }
        } else if (wc == 0) {
#pragma unroll
            for (int ai = 0; ai < 2; ++ai)
#pragma unroll
                for (int m = 0; m < 4; ++m) { float* rp = Sm + (size_t)(row0 + ai * HALF + m * 16) * 32 + 8 * fq;
                    *(f32x4*)rp = acc[ai][0][m][0]; *(f32x4*)(rp + 4) = acc[ai][0][m][1]; }
        }
    }
};
struct EpiRes {
    static constexpr bool PERM = true, AFTER_DRAIN = false;
    const float* base; float* out;
    __device__ __forceinline__ void operator()(const f32x4 (&acc)[2][2][4][2], const Unit& u, int wr, int wc, int fr, int fq) const {
        const int row0 = u.pm * BM + wr * 64 + fr, col0 = u.pn * BM + wc * 32 + 8 * fq;
#pragma unroll
        for (int ai = 0; ai < 2; ++ai)
#pragma unroll
            for (int m = 0; m < 4; ++m) { const size_t off = (size_t)(row0 + ai * HALF + m * 16) * 2048 + col0;
#pragma unroll
                for (int bj = 0; bj < 2; ++bj)
#pragma unroll
                    for (int n = 0; n < 2; ++n) { const f32x4 b4 = *(const f32x4*)(base + off + bj * HALF + 4 * n); *(f32x4*)(out + off + bj * HALF + 4 * n) = b4 + acc[ai][bj][m][n]; } }
    }
};
struct EpiSwiGLU {
    static constexpr bool PERM = true, AFTER_DRAIN = false;
    bf16_t* O;
    __device__ __forceinline__ void operator()(const f32x4 (&acc)[2][2][4][2], const Unit& u, int wr, int wc, int fr, int fq) const {
        const int row0 = u.pm * BM + wr * 64 + fr, col0 = u.pn * 128 + wc * 32 + 8 * fq;
#pragma unroll
        for (int ai = 0; ai < 2; ++ai)
#pragma unroll
            for (int m = 0; m < 4; ++m) { bf16_t* rowp = O + (size_t)(row0 + ai * HALF + m * 16) * 5632 + col0;
                const f32x4 g0 = acc[ai][0][m][0], g1 = acc[ai][0][m][1], u0 = acc[ai][1][m][0], u1 = acc[ai][1][m][1];
                u32x4 w; w.x = cvt_pk_bf16(silu_f(g0[0]) * u0[0], silu_f(g0[1]) * u0[1]); w.y = cvt_pk_bf16(silu_f(g0[2]) * u0[2], silu_f(g0[3]) * u0[3]);
                w.z = cvt_pk_bf16(silu_f(g1[0]) * u1[0], silu_f(g1[1]) * u1[1]); w.w = cvt_pk_bf16(silu_f(g1[2]) * u1[2], silu_f(g1[3]) * u1[3]);
                *(u32x4*)rowp = w; }
    }
};
struct EpiResF2B {
    static constexpr bool PERM = true, AFTER_DRAIN = false;
    const float* base; bf16_t* out; float* ssp;
    __device__ __forceinline__ void operator()(const f32x4 (&acc)[2][2][4][2], const Unit& u, int wr, int wc, int fr, int fq) const {
        const int row0 = u.pm * BM + wr * 64 + fr, col0 = u.pn * BM + wc * 32 + 8 * fq;
#pragma unroll
        for (int ai = 0; ai < 2; ++ai)
#pragma unroll
            for (int m = 0; m < 4; ++m) { const int row = row0 + ai * HALF + m * 16; const size_t off = (size_t)row * 2048 + col0; float ss = 0.f;
#pragma unroll
                for (int bj = 0; bj < 2; ++bj) { const f32x4 v0 = *(const f32x4*)(base + off + bj * HALF) + acc[ai][bj][m][0], v1 = *(const f32x4*)(base + off + bj * HALF + 4) + acc[ai][bj][m][1];
                    ss += (v0[0] * v0[0] + v0[1] * v0[1]) + (v0[2] * v0[2] + v0[3] * v0[3]) + (v1[0] * v1[0] + v1[1] * v1[1]) + (v1[2] * v1[2] + v1[3] * v1[3]);
                    u32x4 w; w.x = cvt_pk_bf16(v0[0], v0[1]); w.y = cvt_pk_bf16(v0[2], v0[3]); w.z = cvt_pk_bf16(v1[0], v1[1]); w.w = cvt_pk_bf16(v1[2], v1[3]);
                    *(u32x4*)(out + off + bj * HALF) = w; }
                ss += __shfl_xor(ss, 16); ss += __shfl_xor(ss, 32);
                if (fq == 0) ssp[(size_t)row * 32 + 4 * u.pn + wc] = ss; }
    }
};
struct EpiResB2B {
    static constexpr bool PERM = true, AFTER_DRAIN = false;
    const bf16_t* base; bf16_t* out;
    __device__ __forceinline__ void operator()(const f32x4 (&acc)[2][2][4][2], const Unit& u, int wr, int wc, int fr, int fq) const {
        const int row0 = u.pm * BM + wr * 64 + fr, col0 = u.pn * BM + wc * 32 + 8 * fq;
#pragma unroll
        for (int ai = 0; ai < 2; ++ai)
#pragma unroll
            for (int m = 0; m < 4; ++m) { const size_t off = (size_t)(row0 + ai * HALF + m * 16) * 2048 + col0;
#pragma unroll
                for (int bj = 0; bj < 2; ++bj) { const u32x4 b4 = *(const u32x4*)(base + off + bj * HALF);
                    const f32x4 v0 = (f32x4){__uint_as_float(b4.x << 16), __uint_as_float(b4.x & 0xffff0000u), __uint_as_float(b4.y << 16), __uint_as_float(b4.y & 0xffff0000u)} + acc[ai][bj][m][0];
                    const f32x4 v1 = (f32x4){__uint_as_float(b4.z << 16), __uint_as_float(b4.z & 0xffff0000u), __uint_as_float(b4.w << 16), __uint_as_float(b4.w & 0xffff0000u)} + acc[ai][bj][m][1];
                    u32x4 w; w.x = cvt_pk_bf16(v0[0], v0[1]); w.y = cvt_pk_bf16(v0[2], v0[3]); w.z = cvt_pk_bf16(v1[0], v1[1]); w.w = cvt_pk_bf16(v1[2], v1[3]);
                    *(u32x4*)(out + off + bj * HALF) = w; } }
    }
};
__device__ __forceinline__ f32x2 silu_mul_pk(f32x2 g, f32x2 u) {
    const f32x2 t = g * (-1.4426950408889634f);
    f32x2 e; e.x = __builtin_amdgcn_exp2f(t.x); e.y = __builtin_amdgcn_exp2f(t.y);
    const f32x2 d = e + 1.0f;
    f32x2 r; r.x = __builtin_amdgcn_rcpf(d.x); r.y = __builtin_amdgcn_rcpf(d.y);
    return (g * u) * r;
}
struct EpiSwiGLUr {
    static constexpr bool PERM = true, AFTER_DRAIN = false;
    bf16_t* O; const float* rstd;
    __device__ __forceinline__ void operator()(const f32x4 (&acc)[2][2][4][2], const Unit& u, int wr, int wc, int fr, int fq) const {
        const int row0 = u.pm * BM + wr * 64 + fr, col0 = u.pn * 128 + wc * 32 + 8 * fq;
#pragma unroll
        for (int ai = 0; ai < 2; ++ai)
#pragma unroll
            for (int m = 0; m < 4; ++m) { const int row = row0 + ai * HALF + m * 16; bf16_t* rowp = O + (size_t)row * 5632 + col0;
                const float rs = rstd[row];
                const f32x4 g0 = acc[ai][0][m][0] * rs, g1 = acc[ai][0][m][1] * rs, u0 = acc[ai][1][m][0] * rs, u1 = acc[ai][1][m][1] * rs;
                const f32x2 a = silu_mul_pk((f32x2){g0[0], g0[1]}, (f32x2){u0[0], u0[1]}), b2 = silu_mul_pk((f32x2){g0[2], g0[3]}, (f32x2){u0[2], u0[3]});
                const f32x2 c = silu_mul_pk((f32x2){g1[0], g1[1]}, (f32x2){u1[0], u1[1]}), d = silu_mul_pk((f32x2){g1[2], g1[3]}, (f32x2){u1[2], u1[3]});
                u32x4 w; w.x = cvt_pk_bf16(a.x, a.y); w.y = cvt_pk_bf16(b2.x, b2.y); w.z = cvt_pk_bf16(c.x, c.y); w.w = cvt_pk_bf16(d.x, d.y);
                *(u32x4*)rowp = w; }
    }
};
template <class Epi, class Sched, bool ALIGN_EPI = false, bool SP2 = false>
__device__ __forceinline__ void gemm_phase(PG8_LAS unsigned char* lds, const Gemm g, const Sched& S, const Epi& E) {
    const int tid = threadIdx.x, wid = __builtin_amdgcn_readfirstlane(tid >> 6), lane = tid & 63, wr = wid >> 2, wc = wid & 3, fr = lane & 15, fq = lane >> 4;
    const int K = g.K, nt = K / BK;
    unsigned voffA[2], voffB[2];
#pragma unroll
    for (int i = 0; i < 2; ++i) { int R, C; stage_rc(tid * 16 + i * 8192, R, C); const int Rb = Epi::PERM ? ((R & ~31) + perm32(R & 31)) : R;
        voffA[i] = (unsigned)(R * K + C) * 2u; voffB[i] = (unsigned)(Rb * K + C) * 2u; }
    const size_t kstep = (size_t)(BK * 2);
    const size_t hstep = (size_t)HALF * K * 2;
    const size_t tstep = 2 * hstep;
    const unsigned ldsw = (unsigned)wid * 1024u;
    const int aoff = lds_byte(wr * 64 + fr, fq * 8), boff = lds_byte(wc * 32 + fr, fq * 8);
#define PG8_SA(b, h) (((b) * 2 + (h)) * HTB)
#define PG8_SB(b, h) ((4 + (b) * 2 + (h)) * HTB)
#define PG8_STAGE(bufoff, gbase, voff) do { _Pragma("unroll") for (int _i = 0; _i < 2; ++_i) \
        __builtin_amdgcn_global_load_lds((const unsigned*)((const char*)(gbase) + (voff)[_i]), (PG8_LAS unsigned*)(lds + (bufoff) + ldsw + _i * 8192), 16, 0, 0); } while (0)
#define PG8_LDA(dst, b, h) do { _Pragma("unroll") for (int m = 0; m < 4; ++m) _Pragma("unroll") for (int k = 0; k < 2; ++k) dst[m][k] = *(const PG8_LAS bf16x8*)(lds + PG8_SA(b, h) + aoff + m * 2048 + k * 1024); } while (0)
#define PG8_LDB(dst, b, h) do { _Pragma("unroll") for (int n = 0; n < 2; ++n) _Pragma("unroll") for (int k = 0; k < 2; ++k) dst[n][k] = *(const PG8_LAS bf16x8*)(lds + PG8_SB(b, h) + boff + n * 2048 + k * 1024); } while (0)
#define PG8_MMA(ai, bj, At, Bt) do { __builtin_amdgcn_s_setprio(1); _Pragma("unroll") for (int m = 0; m < 4; ++m) _Pragma("unroll") for (int n = 0; n < 2; ++n) _Pragma("unroll") for (int k = 0; k < 2; ++k) \
        acc[ai][bj][m][n] = __builtin_amdgcn_mfma_f32_16x16x32_bf16(Bt[n][k], At[m][k], acc[ai][bj][m][n], 0, 0, 0); __builtin_amdgcn_s_setprio(0); } while (0)
#define PG8_WAIT_V(n) asm volatile("s_waitcnt vmcnt(" #n ")" ::: "memory")
#define PG8_WAIT_L(n) asm volatile("s_waitcnt lgkmcnt(" #n ")" ::: "memory")
#define PG8_BAR __builtin_amdgcn_s_barrier()
#define PG8_SCHED __builtin_amdgcn_sched_barrier(0)
    Unit cur, nxt; int ui = 0;
    if (!S.next(0, cur)) return;
    f32x4 acc[2][2][4][2];
#pragma unroll
    for (int a = 0; a < 2; ++a)
#pragma unroll
        for (int b = 0; b < 2; ++b)
#pragma unroll
            for (int m = 0; m < 4; ++m)
#pragma unroll
                for (int n = 0; n < 2; ++n) acc[a][b][m][n] = (f32x4){0.f, 0.f, 0.f, 0.f};
    bf16x8 At[4][2], B0[2][2], B1[2][2];
    const char* cA = (const char*)g.A + (size_t)cur.pm * tstep; const char* cB = (const char*)g.Bt + (size_t)cur.pn * tstep;
    S.a_ready(cur);
    if constexpr (SP2) {
        PG8_STAGE(PG8_SB(0, 0), cB, voffB); PG8_STAGE(PG8_SB(0, 1), cB + hstep, voffB); PG8_STAGE(PG8_SA(0, 0), cA, voffA); PG8_STAGE(PG8_SA(0, 1), cA + hstep, voffA);
        if (wr == 1) PG8_BAR;
        PG8_WAIT_V(2); PG8_BAR;
        PG8_STAGE(PG8_SB(1, 0), cB + kstep, voffB); PG8_STAGE(PG8_SA(1, 0), cA + kstep, voffA); PG8_STAGE(PG8_SB(1, 1), cB + hstep + kstep, voffB);
        PG8_WAIT_V(6); PG8_BAR;
    } else {
        PG8_STAGE(PG8_SB(0, 0), cB, voffB); PG8_STAGE(PG8_SA(0, 0), cA, voffA); PG8_STAGE(PG8_SB(0, 1), cB + hstep, voffB); PG8_STAGE(PG8_SA(0, 1), cA + hstep, voffA);
        if (wr == 1) PG8_BAR;
        PG8_WAIT_V(4); PG8_BAR;
        PG8_STAGE(PG8_SB(1, 0), cB + kstep, voffB); PG8_STAGE(PG8_SA(1, 0), cA + kstep, voffA); PG8_STAGE(PG8_SB(1, 1), cB + hstep + kstep, voffB);
        PG8_WAIT_V(6); PG8_BAR;
    }
    for (;;) {
        const bool has_next = S.next(ui + 1, nxt);
        const char* nA = has_next ? (const char*)g.A + (size_t)nxt.pm * tstep : cA; const char* nB = has_next ? (const char*)g.Bt + (size_t)nxt.pn * tstep : cB;
        for (int t = 0; t < nt; t += 2) {
            const bool last = (t == nt - 2);
            const char* a1 = cA + (size_t)(t + 1) * kstep;
            const char* a2 = last ? nA : cA + (size_t)(t + 2) * kstep; const char* b2 = last ? nB : cB + (size_t)(t + 2) * kstep;
            const char* a3 = a2 + kstep; const char* b3 = b2 + kstep;
            if (last && has_next) S.a_ready(nxt);
            if constexpr (SP2) {
            PG8_LDB(B0, 0, 0); PG8_LDB(B1, 0, 1); PG8_SCHED; PG8_LDA(At, 0, 0); PG8_STAGE(PG8_SA(1, 1), a1 + hstep, voffA);
            PG8_WAIT_V(8); PG8_WAIT_L(0); PG8_BAR; PG8_MMA(0, 0, At, B0); PG8_MMA(0, 1, At, B1); PG8_BAR; PG8_SCHED;
            PG8_LDA(At, 0, 1); PG8_STAGE(PG8_SB(0, 0), b2, voffB); PG8_STAGE(PG8_SB(0, 1), b2 + hstep, voffB); PG8_STAGE(PG8_SA(0, 0), a2, voffA);
            PG8_WAIT_V(8); PG8_WAIT_L(0); PG8_BAR; PG8_MMA(1, 0, At, B0); PG8_MMA(1, 1, At, B1); PG8_BAR; PG8_SCHED;
            PG8_LDB(B0, 1, 0); PG8_LDB(B1, 1, 1); PG8_SCHED; PG8_LDA(At, 1, 0); PG8_STAGE(PG8_SA(0, 1), a2 + hstep, voffA);
            PG8_WAIT_V(8); PG8_WAIT_L(0); PG8_BAR; PG8_MMA(0, 0, At, B0); PG8_MMA(0, 1, At, B1); PG8_BAR; PG8_SCHED;
            PG8_LDA(At, 1, 1); PG8_STAGE(PG8_SB(1, 0), b3, voffB); PG8_STAGE(PG8_SB(1, 1), b3 + hstep, voffB); PG8_STAGE(PG8_SA(1, 0), a3, voffA);
            PG8_WAIT_V(8); PG8_WAIT_L(0); PG8_BAR; PG8_MMA(1, 0, At, B0); PG8_MMA(1, 1, At, B1); PG8_BAR; PG8_SCHED;
            } else {
            PG8_LDB(B0, 0, 0); PG8_SCHED; PG8_LDA(At, 0, 0); PG8_STAGE(PG8_SA(1, 1), a1 + hstep, voffA);
            PG8_WAIT_L(8); PG8_BAR; PG8_WAIT_L(0); PG8_MMA(0, 0, At, B0); PG8_BAR; PG8_SCHED;
            PG8_LDB(B1, 0, 1); PG8_STAGE(PG8_SB(0, 0), b2, voffB);
            PG8_BAR; PG8_WAIT_L(0); PG8_MMA(0, 1, At, B1); PG8_BAR;
            PG8_LDA(At, 0, 1); PG8_STAGE(PG8_SA(0, 0), a2, voffA);
            PG8_BAR; PG8_WAIT_L(0); PG8_MMA(1, 0, At, B0); PG8_BAR; PG8_SCHED;
            PG8_STAGE(PG8_SB(0, 1), b2 + hstep, voffB);
            PG8_WAIT_V(6); PG8_BAR; PG8_MMA(1, 1, At, B1); PG8_BAR;
            PG8_LDB(B0, 1, 0); PG8_SCHED; PG8_LDA(At, 1, 0); PG8_STAGE(PG8_SA(0, 1), a2 + hstep, voffA);
            PG8_WAIT_L(8); PG8_BAR; PG8_WAIT_L(0); PG8_MMA(0, 0, At, B0); PG8_BAR; PG8_SCHED;
            PG8_LDB(B1, 1, 1); PG8_STAGE(PG8_SB(1, 0), b3, voffB);
            PG8_BAR; PG8_WAIT_L(0); PG8_MMA(0, 1, At, B1); PG8_BAR;
            PG8_LDA(At, 1, 1); PG8_STAGE(PG8_SA(1, 0), a3, voffA);
            PG8_BAR; PG8_WAIT_L(0); PG8_MMA(1, 0, At, B0); PG8_BAR; PG8_SCHED;
            PG8_STAGE(PG8_SB(1, 1), b3 + hstep, voffB);
            PG8_WAIT_V(6); PG8_BAR; PG8_MMA(1, 1, At, B1); PG8_BAR;
            }
        }
        if constexpr (ALIGN_EPI) { if (wr == 0) PG8_BAR; }
        if constexpr (!Epi::AFTER_DRAIN) { E(acc, cur, wr, wc, fr, fq); S.done(cur); }
        if (!has_next) break;
#pragma unroll
        for (int a = 0; a < 2; ++a)
#pragma unroll
            for (int b = 0; b < 2; ++b)
#pragma unroll
                for (int m = 0; m < 4; ++m)
#pragma unroll
                    for (int n = 0; n < 2; ++n) acc[a][b][m][n] = (f32x4){0.f, 0.f, 0.f, 0.f};
        cur = nxt; cA = nA; cB = nB; ++ui;
        if constexpr (ALIGN_EPI) { if (wr == 1) PG8_BAR; }
    }
    PG8_WAIT_V(0);
    if constexpr (!ALIGN_EPI) { if (wr == 0) PG8_BAR; }
    PG8_BAR;
    if constexpr (Epi::AFTER_DRAIN) { E.fused(acc, cur, wr, wc, fr, fq, lds, wid, lane); S.done(cur); }
#undef PG8_SA
#undef PG8_SB
#undef PG8_STAGE
#undef PG8_LDA
#undef PG8_LDB
#undef PG8_MMA
#undef PG8_WAIT_V
#undef PG8_WAIT_L
#undef PG8_BAR
#undef PG8_SCHED
}
}
constexpr int NB = 4, SEQ = 8192, NMETA = 16, DM = 2048, MX = NB * SEQ  , META0 = MX  , MP = 33024  ;
constexpr int NCH = 129;
constexpr int PROJ_LD = 7168, NIN_P = 7424, DFF = 5632;
constexpr float EPS = 1e-6f;
constexpr size_t MiB = 1u << 20;
constexpr size_t WS_SMALL = 0;
constexpr size_t WS_GL    = 5 * MiB;
constexpr size_t WS_WIN   = 6 * MiB;
constexpr size_t WS_WOUT  = WS_WIN + 29 * MiB;
constexpr size_t WS_WGU   = WS_WOUT + 8 * MiB;
constexpr size_t WS_WDN   = WS_WGU + 44 * MiB;
constexpr size_t WS_NBUF  = WS_WDN + 22 * MiB;
constexpr size_t WS_PROJ  = WS_NBUF + 129 * MiB;
constexpr size_t WS_GDN   = WS_PROJ + 452 * MiB;
constexpr size_t WS_END   = WS_GDN + 319 * MiB;
constexpr int GDN_ITEM = 80896, GLA_ITEM = 82432;
constexpr int P3_BUF = 67072;
static_assert((size_t)MP * PROJ_LD * 2 <= 452 * MiB && (size_t)4128 * GDN_ITEM <= 319 * MiB && (size_t)2064 * GLA_ITEM <= (size_t)MX * DM * 4 && WS_END <= 1024 * MiB, "ws map");
constexpr int LDS_BYTES = 147456 + 64;

#define DI __device__ __forceinline__
typedef unsigned short bf16;
typedef float f32x4 __attribute__((ext_vector_type(4)));
typedef float f32x16 __attribute__((ext_vector_type(16)));
typedef short bf16x8 __attribute__((ext_vector_type(8)));
typedef unsigned short u16x4 __attribute__((ext_vector_type(4)));
typedef unsigned u32x4 __attribute__((ext_vector_type(4)));
typedef unsigned u32x2 __attribute__((ext_vector_type(2)));
typedef float f32x2_t __attribute__((ext_vector_type(2)));
typedef __bf16 bf16x2_t __attribute__((ext_vector_type(2)));
DI unsigned pk2(float lo, float hi) { f32x2_t v = {lo, hi}; bf16x2_t b = __builtin_convertvector(v, bf16x2_t); return __builtin_bit_cast(unsigned, b); }
DI bf16 f2bf(float f) { return (bf16)(pk2(f, 0.f) & 0xffffu); }
DI float bf2f(bf16 b) { return __uint_as_float((unsigned)b << 16); }
DI float bflo(unsigned w) { return __uint_as_float(w << 16); }
DI float bfhi(unsigned w) { return __uint_as_float(w & 0xffff0000u); }
#define MFMA32(a, b, c) __builtin_amdgcn_mfma_f32_32x32x16_bf16((a), (b), (c), 0, 0, 0)
DI int crow(int reg, int hh) { return (reg & 3) + 8 * (reg >> 2) + 4 * hh; }
DI int perm16(int k) { return 8 * ((k >> 2) & 1) + 4 * (k >> 3) + (k & 3); }
DI float wave_sum(float v) {
#pragma unroll
    for (int o = 1; o < 64; o <<= 1) v += __shfl_xor(v, o);
    return v;
}
DI float xor1(float v) { return __int_as_float(__builtin_amdgcn_update_dpp(0, __float_as_int(v), 0xB1, 0xF, 0xF, true)); }
DI int row_of(int b, int p) { return p < NMETA ? META0 + b * NMETA + p : b * SEQ + p - NMETA; }
DI float sigmoid_f(float x) { return __builtin_amdgcn_rcpf(1.0f + __expf(-x)); }
DI float silu_f(float x) { return x * sigmoid_f(x); }
#define LDS_WAIT() asm volatile("s_waitcnt lgkmcnt(0)" ::: "memory")

struct Args { const float* in[17]; float* out; unsigned char* ws; int ph_lo, ph_hi; };

DI int map_row(int mode, int n) {
    if (mode == 0) return n < 4096 ? n : (n < 4112 ? 7168 + (n - 4096) : (n < 7184 ? n - 16 : n));
    if (mode == 1) return (n >> 7) * 256 + (n & 127);
    if (mode == 2) return (n >> 7) * 256 + 128 + (n & 127);
    return n;
}
DI void transpose_load(const float* W, int N, int item, int lane, float (&tv)[32]) {
    const int nblk = N / 32, kb = item / nblk, nb = item % nblk, k0 = 64 * kb, n0 = 32 * nb;
#pragma unroll
    for (int i = 0; i < 32; ++i) { const int kk = 2 * i + (lane >> 5); tv[i] = W[(size_t)(k0 + kk) * N + n0 + (lane & 31)]; }
}
DI void transpose_store(const float (&tv)[32], int K, int N, bf16* WT, int mode, float* scr, int item, int lane, const float* kscale) {
    const int nblk = N / 32, kb = item / nblk, nb = item % nblk, k0 = 64 * kb, n0 = 32 * nb;
#pragma unroll
    for (int i = 0; i < 32; ++i) { const int kk = 2 * i + (lane >> 5); scr[kk * 33 + (lane & 31)] = tv[i]; }
    LDS_WAIT();
    const int c = lane & 7;
#pragma unroll
    for (int j = 0; j < 4; ++j) { const int n = (lane >> 3) + 8 * j; const float* s = scr + (8 * c) * 33 + n;
        f32x4 k0v = {1.f, 1.f, 1.f, 1.f}, k1v = {1.f, 1.f, 1.f, 1.f};
        if (mode == 1 || mode == 2) { k0v = *(const f32x4*)(kscale + k0 + 8 * c); k1v = *(const f32x4*)(kscale + k0 + 8 * c + 4); }
        u32x4 o; o.x = pk2(s[0 * 33] * k0v.x, s[1 * 33] * k0v.y); o.y = pk2(s[2 * 33] * k0v.z, s[3 * 33] * k0v.w); o.z = pk2(s[4 * 33] * k1v.x, s[5 * 33] * k1v.y); o.w = pk2(s[6 * 33] * k1v.z, s[7 * 33] * k1v.w);
        *(u32x4*)(WT + (size_t)map_row(mode, n0 + n) * K + k0 + 8 * c) = o; }
    LDS_WAIT();
}
DI void p0_item(const Args& a, int it, const float*& W, bf16*& WT, int& K, int& N, int& mode, int& item) {
    constexpr int I_IN = 32 * 225, I_OUT = 32 * 64, I_G = 32 * 176;
    unsigned char* ws = a.ws;
    const int sel = it < I_IN ? 0 : (it < I_IN + I_OUT ? 1 : (it < I_IN + I_OUT + I_G ? 2 : (it < I_IN + I_OUT + 2 * I_G ? 3 : 4)));
    item = it - (sel == 0 ? 0 : (sel == 1 ? I_IN : (sel == 2 ? I_IN + I_OUT : (sel == 3 ? I_IN + I_OUT + I_G : I_IN + I_OUT + 2 * I_G))));
    W = sel == 0 ? a.in[3] : (sel == 1 ? a.in[11] : (sel == 2 ? a.in[13] : (sel == 3 ? a.in[14] : a.in[15])));
    WT = (bf16*)(ws + (sel == 0 ? WS_WIN : (sel == 1 ? WS_WOUT : (sel == 4 ? WS_WDN : WS_WGU))));
    K = sel == 4 ? DFF : DM; N = sel == 0 ? 7200 : ((sel == 1 || sel == 4) ? DM : DFF); mode = sel == 0 ? 0 : (sel == 2 ? 1 : (sel == 3 ? 2 : 3));
}
DI void rms_row_bf16(const float* xrow, const float* w, bf16* orow, int lane) {
    const f32x4* xr = (const f32x4*)xrow + lane; const f32x4* wr = (const f32x4*)w + lane;
    f32x4 v[8], wv[8]; float s = 0.f;
#pragma unroll
    for (int j = 0; j < 8; ++j) v[j] = xr[64 * j];
#pragma unroll
    for (int j = 0; j < 8; ++j) wv[j] = wr[64 * j];
#pragma unroll
    for (int j = 0; j < 8; ++j) s += (v[j].x * v[j].x + v[j].y * v[j].y) + (v[j].z * v[j].z + v[j].w * v[j].w);
    const float rstd = rsqrtf(wave_sum(s) * (1.f / DM) + EPS);
    u32x2* o8 = (u32x2*)orow + lane;
#pragma unroll
    for (int j = 0; j < 8; ++j) { const f32x4 ww = wv[j]; u32x2 o; o.x = pk2(v[j].x * rstd * ww.x, v[j].y * rstd * ww.y); o.y = pk2(v[j].z * rstd * ww.z, v[j].w * rstd * ww.w); o8[64 * j] = o; }
}
DI void rms_row_f32(const float* xrow, const float* w, float* orow, int lane) {
    const f32x4* xr = (const f32x4*)xrow + lane; const f32x4* wr = (const f32x4*)w + lane;
    f32x4 v[8]; float s = 0.f;
#pragma unroll
    for (int j = 0; j < 8; ++j) { v[j] = xr[64 * j]; s += (v[j].x * v[j].x + v[j].y * v[j].y) + (v[j].z * v[j].z + v[j].w * v[j].w); }
    const float rstd = rsqrtf(wave_sum(s) * (1.f / DM) + EPS);
    f32x4* o = (f32x4*)orow + lane;
#pragma unroll
    for (int j = 0; j < 8; ++j) { const f32x4 ww = wr[64 * j]; o[64 * j] = v[j] * rstd * ww; }
}
DI void rms_rows2_bf16(const float* x0, const float* x1, const float* w, bf16* o0, bf16* o1, int lane) {
    const f32x4* xr0 = (const f32x4*)x0 + lane; const f32x4* xr1 = (const f32x4*)x1 + lane; const f32x4* wr = (const f32x4*)w + lane;
    f32x4 v0[8], v1[8], wv[8]; float s0 = 0.f, s1 = 0.f;
#pragma unroll
    for (int j = 0; j < 8; ++j) { v0[j] = xr0[64 * j]; v1[j] = xr1[64 * j]; }
#pragma unroll
    for (int j = 0; j < 8; ++j) wv[j] = wr[64 * j];
#pragma unroll
    for (int j = 0; j < 8; ++j) { s0 += (v0[j].x * v0[j].x + v0[j].y * v0[j].y) + (v0[j].z * v0[j].z + v0[j].w * v0[j].w); s1 += (v1[j].x * v1[j].x + v1[j].y * v1[j].y) + (v1[j].z * v1[j].z + v1[j].w * v1[j].w); }
    const float r0 = rsqrtf(wave_sum(s0) * (1.f / DM) + EPS), r1 = rsqrtf(wave_sum(s1) * (1.f / DM) + EPS);
    u32x2* p0 = (u32x2*)o0 + lane; u32x2* p1 = (u32x2*)o1 + lane;
#pragma unroll
    for (int j = 0; j < 8; ++j) { const f32x4 ww = wv[j]; u32x2 a, b;
        a.x = pk2(v0[j].x * r0 * ww.x, v0[j].y * r0 * ww.y); a.y = pk2(v0[j].z * r0 * ww.z, v0[j].w * r0 * ww.w);
        b.x = pk2(v1[j].x * r1 * ww.x, v1[j].y * r1 * ww.y); b.y = pk2(v1[j].z * r1 * ww.z, v1[j].w * r1 * ww.w);
        p0[64 * j] = a; p1[64 * j] = b; }
}
DI void rms_rows2_f32(const float* x0, const float* x1, const float* w, float* o0, float* o1, int lane) {
    const f32x4* xr0 = (const f32x4*)x0 + lane; const f32x4* xr1 = (const f32x4*)x1 + lane; const f32x4* wr = (const f32x4*)w + lane;
    f32x4 v0[8], v1[8], wv[8]; float s0 = 0.f, s1 = 0.f;
#pragma unroll
    for (int j = 0; j < 8; ++j) { v0[j] = xr0[64 * j]; v1[j] = xr1[64 * j]; }
#pragma unroll
    for (int j = 0; j < 8; ++j) wv[j] = wr[64 * j];
#pragma unroll
    for (int j = 0; j < 8; ++j) { s0 += (v0[j].x * v0[j].x + v0[j].y * v0[j].y) + (v0[j].z * v0[j].z + v0[j].w * v0[j].w); s1 += (v1[j].x * v1[j].x + v1[j].y * v1[j].y) + (v1[j].z * v1[j].z + v1[j].w * v1[j].w); }
    const float r0 = rsqrtf(wave_sum(s0) * (1.f / DM) + EPS), r1 = rsqrtf(wave_sum(s1) * (1.f / DM) + EPS);
    f32x4* p0 = (f32x4*)o0 + lane; f32x4* p1 = (f32x4*)o1 + lane;
#pragma unroll
    for (int j = 0; j < 8; ++j) { p0[64 * j] = v0[j] * r0 * wv[j]; p1[64 * j] = v1[j] * r1 * wv[j]; }
}
DI void rms_rows2_b2b(const bf16* x0, const bf16* x1, const float* w, bf16* o0, bf16* o1, int lane) {
    const u32x4* xr0 = (const u32x4*)x0 + lane; const u32x4* xr1 = (const u32x4*)x1 + lane;
    u32x4 v0[4], v1[4]; f32x4 wv[4][2]; float s0 = 0.f, s1 = 0.f;
#pragma unroll
    for (int j = 0; j < 4; ++j) { v0[j] = xr0[64 * j]; v1[j] = xr1[64 * j]; }
#pragma unroll
    for (int j = 0; j < 4; ++j) { const float* wp = w + 8 * lane + 512 * j; wv[j][0] = *(const f32x4*)wp; wv[j][1] = *(const f32x4*)(wp + 4); }
    float a0[4][8], a1[4][8];
#pragma unroll
    for (int j = 0; j < 4; ++j) {
        const unsigned p0[4] = {v0[j].x, v0[j].y, v0[j].z, v0[j].w}, p1[4] = {v1[j].x, v1[j].y, v1[j].z, v1[j].w};
#pragma unroll
        for (int e = 0; e < 4; ++e) { a0[j][2 * e] = bflo(p0[e]); a0[j][2 * e + 1] = bfhi(p0[e]); a1[j][2 * e] = bflo(p1[e]); a1[j][2 * e + 1] = bfhi(p1[e]); }
#pragma unroll
        for (int e = 0; e < 8; ++e) { s0 += a0[j][e] * a0[j][e]; s1 += a1[j][e] * a1[j][e]; } }
    const float r0 = rsqrtf(wave_sum(s0) * (1.f / DM) + EPS), r1 = rsqrtf(wave_sum(s1) * (1.f / DM) + EPS);
    u32x4* q0 = (u32x4*)o0 + lane; u32x4* q1 = (u32x4*)o1 + lane;
#pragma unroll
    for (int j = 0; j < 4; ++j) { const float ww[8] = {wv[j][0].x, wv[j][0].y, wv[j][0].z, wv[j][0].w, wv[j][1].x, wv[j][1].y, wv[j][1].z, wv[j][1].w};
        u32x4 oa, ob;
        oa.x = pk2(a0[j][0] * r0 * ww[0], a0[j][1] * r0 * ww[1]); oa.y = pk2(a0[j][2] * r0 * ww[2], a0[j][3] * r0 * ww[3]); oa.z = pk2(a0[j][4] * r0 * ww[4], a0[j][5] * r0 * ww[5]); oa.w = pk2(a0[j][6] * r0 * ww[6], a0[j][7] * r0 * ww[7]);
        ob.x = pk2(a1[j][0] * r1 * ww[0], a1[j][1] * r1 * ww[1]); ob.y = pk2(a1[j][2] * r1 * ww[2], a1[j][3] * r1 * ww[3]); ob.z = pk2(a1[j][4] * r1 * ww[4], a1[j][5] * r1 * ww[5]); ob.w = pk2(a1[j][6] * r1 * ww[6], a1[j][7] * r1 * ww[7]);
        q0[64 * j] = oa; q1[64 * j] = ob; }
}
DI void rms_rows2_b2f(const bf16* x0, const bf16* x1, const float* w, float* o0, float* o1, int lane) {
    const u32x4* xr0 = (const u32x4*)x0 + lane; const u32x4* xr1 = (const u32x4*)x1 + lane;
    u32x4 v0[4], v1[4]; f32x4 wv[4][2]; float s0 = 0.f, s1 = 0.f;
#pragma unroll
    for (int j = 0; j < 4; ++j) { v0[j] = xr0[64 * j]; v1[j] = xr1[64 * j]; }
#pragma unroll
    for (int j = 0; j < 4; ++j) { const float* wp = w + 8 * lane + 512 * j; wv[j][0] = *(const f32x4*)wp; wv[j][1] = *(const f32x4*)(wp + 4); }
    float a0[4][8], a1[4][8];
#pragma unroll
    for (int j = 0; j < 4; ++j) {
        const unsigned p0[4] = {v0[j].x, v0[j].y, v0[j].z, v0[j].w}, p1[4] = {v1[j].x, v1[j].y, v1[j].z, v1[j].w};
#pragma unroll
        for (int e = 0; e < 4; ++e) { a0[j][2 * e] = bflo(p0[e]); a0[j][2 * e + 1] = bfhi(p0[e]); a1[j][2 * e] = bflo(p1[e]); a1[j][2 * e + 1] = bfhi(p1[e]); }
#pragma unroll
        for (int e = 0; e < 8; ++e) { s0 += a0[j][e] * a0[j][e]; s1 += a1[j][e] * a1[j][e]; } }
    const float r0 = rsqrtf(wave_sum(s0) * (1.f / DM) + EPS), r1 = rsqrtf(wave_sum(s1) * (1.f / DM) + EPS);
#pragma unroll
    for (int j = 0; j < 4; ++j) { float* q0 = o0 + 8 * lane + 512 * j; float* q1 = o1 + 8 * lane + 512 * j;
        *(f32x4*)q0 = (f32x4){a0[j][0], a0[j][1], a0[j][2], a0[j][3]} * r0 * wv[j][0]; *(f32x4*)(q0 + 4) = (f32x4){a0[j][4], a0[j][5], a0[j][6], a0[j][7]} * r0 * wv[j][1];
        *(f32x4*)q1 = (f32x4){a1[j][0], a1[j][1], a1[j][2], a1[j][3]} * r1 * wv[j][0]; *(f32x4*)(q1 + 4) = (f32x4){a1[j][4], a1[j][5], a1[j][6], a1[j][7]} * r1 * wv[j][1]; }
}
DI void p0_prep(const Args& a, unsigned char* lds, int tid, int G) {
    const int lane = tid & 63, wave = tid >> 6, gw = blockIdx.x * 8 + wave, NGW = G * 8;
    float* scr = (float*)(lds + wave * 16384);
    unsigned char* ws = a.ws;
    bf16* win = (bf16*)(ws + WS_WIN); bf16* wout = (bf16*)(ws + WS_WOUT); bf16* wgu = (bf16*)(ws + WS_WGU); bf16* wdn = (bf16*)(ws + WS_WDN); bf16* nb = (bf16*)(ws + WS_NBUF);
    constexpr int I_IN = 32 * 225, I_OUT = 32 * 64, I_G = 32 * 176, I_D = 88 * 64, NITEMS = I_IN + I_OUT + 2 * I_G + I_D;
    for (int it = gw; it < NITEMS; it += 2 * NGW) {
        float tv0[32], tv1[32];
        const float* W0; bf16* T0; int K0, N0, m0, i0; const float* W1; bf16* T1; int K1, N1, m1, i1;
        const bool has1 = it + NGW < NITEMS;
        p0_item(a, it, W0, T0, K0, N0, m0, i0); p0_item(a, has1 ? it + NGW : it, W1, T1, K1, N1, m1, i1);
        transpose_load(W0, N0, i0, lane, tv0);
        if (has1) transpose_load(W1, N1, i1, lane, tv1);
        transpose_store(tv0, K0, N0, T0, m0, scr, i0, lane, a.in[12]);
        if (has1) transpose_store(tv1, K1, N1, T1, m1, scr, i1, lane, a.in[12]);
    }
    { const int gt = blockIdx.x * 512 + tid, GT = G * 512; const u32x4 z = {0u, 0u, 0u, 0u};
      u32x4* zw = (u32x4*)(win + (size_t)7200 * DM); for (int i = gt; i < 224 * 256; i += GT) zw[i] = z;
      u32x4* zn = (u32x4*)(nb + (size_t)(META0 + NB * NMETA) * DM); for (int i = gt; i < 192 * 256; i += GT) zn[i] = z; }
    for (int m = 2 * gw; m < MX + NB * NMETA; m += 2 * NGW) {
        const float* s0 = m < MX ? a.in[0] + (size_t)m * DM : a.in[1] + (size_t)((m - MX) & 15) * DM;
        const float* s1 = m < MX ? s0 + DM : a.in[1] + (size_t)((m + 1 - MX) & 15) * DM;
        rms_rows2_bf16(s0, s1, a.in[2], nb + (size_t)m * DM, nb + (size_t)(m + 1) * DM, lane);
    }
}

DI void p1_tail(const Args& a, unsigned char* lds, int tid, int bx, int G) {
    const int lane = tid & 63, wave = tid >> 6, r = lane & 31, hh = lane >> 5;
    const bf16* nbuf = (const bf16*)(a.ws + WS_NBUF); const bf16* win = (const bf16*)(a.ws + WS_WIN);
    bf16* proj = (bf16*)(a.ws + WS_PROJ); float* small = (float*)(a.ws + WS_SMALL);
    float* red = (float*)lds;
    for (int u = bx; u < 256; u += G) {
        f32x16 acc[4];
#pragma unroll
        for (int mt = 0; mt < 4; ++mt) for (int i = 0; i < 16; ++i) acc[mt][i] = 0.f;
        const bf16* bp = win + (size_t)(7168 + r) * DM + 256 * wave + 8 * hh; const bf16* ap = nbuf + (size_t)(128 * u + r) * DM + 256 * wave + 8 * hh;
#pragma unroll 4
        for (int s_ = 0; s_ < 16; ++s_) { const bf16x8 bf = *(const bf16x8*)(bp + 16 * s_);
#pragma unroll
            for (int mt = 0; mt < 4; ++mt) { const bf16x8 af = *(const bf16x8*)(ap + (size_t)(32 * mt) * DM + 16 * s_); acc[mt] = MFMA32(af, bf, acc[mt]); } }
#pragma unroll
        for (int mt = 0; mt < 4; ++mt)
#pragma unroll
            for (int i = 0; i < 16; ++i) red[wave * 4096 + (mt * 16 + i) * 64 + lane] = acc[mt][i];
        __syncthreads();
#pragma unroll
        for (int j = 0; j < 8; ++j) { const int o = tid + 512 * j; float sum = 0.f;
#pragma unroll
            for (int w = 0; w < 8; ++w) sum += red[w * 4096 + o];
            const int lo = o & 63, i = (o >> 6) & 15, mt = o >> 10; small[(size_t)(128 * u + 32 * mt + crow(i, lo >> 5)) * 32 + (lo & 31)] = sum; }
        __syncthreads();
    }
    for (int g = bx; g < 225; g += G) {
        f32x16 acc; for (int i = 0; i < 16; ++i) acc[i] = 0.f;
        const bf16* bp = win + (size_t)(32 * g + r) * DM + 256 * wave + 8 * hh; const bf16* ap = nbuf + (size_t)(META0 + (r & 15)) * DM + 256 * wave + 8 * hh;
#pragma unroll 4
        for (int s_ = 0; s_ < 16; ++s_) { const bf16x8 bf = *(const bf16x8*)(bp + 16 * s_); const bf16x8 af = *(const bf16x8*)(ap + 16 * s_); acc = MFMA32(af, bf, acc); }
#pragma unroll
        for (int i = 0; i < 16; ++i) red[wave * 1024 + i * 64 + lane] = acc[i];
        __syncthreads();
#pragma unroll
        for (int j = 0; j < 2; ++j) { const int o = tid + 512 * j; float sum = 0.f;
#pragma unroll
            for (int w = 0; w < 8; ++w) sum += red[w * 1024 + o];
            const int lo = o & 63, i = o >> 6, row16 = crow(i, lo >> 5), c = lo & 31;
            if (row16 < 16) {
#pragma unroll
                for (int b = 0; b < NB; ++b) { const size_t row = (size_t)(META0 + NMETA * b + row16);
                    if (g < 224) proj[row * PROJ_LD + 32 * g + c] = f2bf(sum); else small[row * 32 + c] = sum; } } }
        __syncthreads();
    }
}

#define SB() __builtin_amdgcn_sched_barrier(0)
#define LBAR_NOBAR() asm volatile("s_waitcnt lgkmcnt(0)" ::: "memory")
#define LBAR() do { asm volatile("s_waitcnt lgkmcnt(0)" ::: "memory"); __builtin_amdgcn_s_barrier(); asm volatile("" ::: "memory"); } while (0)
DI void gdn_stage_raw(const Args& a, unsigned char* lds, int item, int t, int nt) {
    const int h = item & 7, bc = item >> 3, c = bc % NCH, b = bc / NCH, p0 = c * 64 - 48;
    bf16* RAW = (bf16*)lds; const bf16* proj = (const bf16*)(a.ws + WS_PROJ);
    const int nit = (67 * 48 + nt - 1) / nt;
    for (int k0 = 0; k0 < nit; k0 += 7) {
        u32x4 v[7];
#pragma unroll
        for (int k = 0; k < 7; ++k) { const int idx = min(t + (k0 + k) * nt, 67 * 48 - 1); const int rr = idx / 48, ch = idx % 48, mat = ch >> 4, cc = ch & 15, p = p0 + rr - 3;
            v[k] = *(const u32x4*)(proj + (size_t)row_of(b, max(p, 0)) * PROJ_LD + mat * 1024 + h * 128 + cc * 8); if (p < 0) v[k] = (u32x4){0u, 0u, 0u, 0u}; }
#pragma unroll
        for (int k = 0; k < 7; ++k) { const int idx = t + (k0 + k) * nt; if (k0 + k < nit && idx < 67 * 48) { const int rr = idx / 48, ch = idx % 48; *(u32x4*)(RAW + rr * 392 + (ch >> 4) * 128 + (ch & 15) * 8) = v[k]; } }
    }
}
DI void gdn_gates(const Args& a, float* GCb, int item, int lane) {
    const int h = item & 7, bc = item >> 3, c = bc % NCH, b = bc / NCH, p = c * 64 - 48 + lane;
    const float* small = (const float*)(a.ws + WS_SMALL);
    float beta = 0.f, g = 0.f;
    { const float* sr = small + (size_t)row_of(b, max(p, 0)) * 32; const float av = sr[h], bv = sr[8 + h];
        beta = sigmoid_f(bv); const float xs = av + a.in[6][h]; const float sp = fmaxf(xs, 0.f) + log1pf(__expf(-fabsf(xs)));
        g = -__expf(a.in[5][h]) * sp; if (p < 0) { beta = 0.f; g = 0.f; } }
#pragma unroll
    for (int off = 1; off < 64; off <<= 1) { const float t = __shfl_up(g, off); if (lane >= off) g += t; }
    GCb[lane] = g; GCb[64 + lane] = beta;
}
DI void p2_gdn_item(const Args& a, unsigned char* lds, int item, int next, int par, int tid) {
    const int h = item & 7, bc = item >> 3, c = bc % NCH, b = bc / NCH;
    const int lane = tid & 63, wv = tid >> 6;
    bf16* RAW = (bf16*)lds;
    bf16* QB = (bf16*)(lds + 53248);
    bf16* KB = (bf16*)(lds + 53248 + 17408);
    float* AMD = (float*)(lds + 88064);
    bf16* RHS = (bf16*)(lds + 106496);
    float* GC = (float*)(lds + 140288) + 128 * par;
    float* BETA = GC + 64;
    unsigned char* it = a.ws + WS_GDN + (size_t)item * GDN_ITEM;
    bf16* o_w = (bf16*)it; bf16* o_qd = (bf16*)(it + 17408); bf16* o_kdT = (bf16*)(it + 34816); bf16* o_qk = (bf16*)(it + 53248); bf16* o_uT = (bf16*)(it + 62464);
    const int p0 = c * 64 - 48;
#ifndef REPS1
#define REPS1 1
#define REPS2 1
#define REPS3 1
#endif
    for (int rep_ = 0; rep_ < REPS1; ++rep_) {
        const int cgi = tid & 15, tq = tid >> 4, t0 = 2 * tq;
        const float* cw = (const float*)(lds + 141312);
#pragma unroll
        for (int mat = 0; mat < 3; ++mat) {
            f32x4 w4[4][2];
#pragma unroll
            for (int i = 0; i < 4; ++i) { const float* wp = cw + i * 384 + mat * 128 + cgi * 8; w4[i][0] = *(const f32x4*)wp; w4[i][1] = *(const f32x4*)(wp + 4); }
            float y[2][8];
#pragma unroll
            for (int tt = 0; tt < 2; ++tt)
#pragma unroll
                for (int e = 0; e < 8; ++e) y[tt][e] = 0.f;
#pragma unroll
            for (int rr = 0; rr < 5; ++rr) {
                const u32x4 rv = *(const u32x4*)(RAW + (t0 + rr) * 392 + mat * 128 + cgi * 8);
                float x[8] = {bflo(rv.x), bfhi(rv.x), bflo(rv.y), bfhi(rv.y), bflo(rv.z), bfhi(rv.z), bflo(rv.w), bfhi(rv.w)};
#pragma unroll
                for (int tt = 0; tt < 2; ++tt) { const int i = rr - tt; if (i >= 0 && i < 4) {
#pragma unroll
                    for (int e = 0; e < 8; ++e) y[tt][e] += w4[i][e >> 2][e & 3] * x[e]; } }
            }
#pragma unroll
            for (int tt = 0; tt < 2; ++tt) {
                const int t = t0 + tt; const bool valid = (p0 + t) >= 0;
                float s[8]; float ss = 0.f;
#pragma unroll
                for (int e = 0; e < 8; ++e) { s[e] = valid ? silu_f(y[tt][e]) : 0.f; ss += s[e] * s[e]; }
                const float gct = GC[t], eg = __expf(gct), bt = BETA[t];
                if (mat < 2) {
                    ss += __shfl_xor(ss, 1); ss += __shfl_xor(ss, 2); ss += __shfl_xor(ss, 4); ss += __shfl_xor(ss, 8);
                    const float rn = rsqrtf(ss + EPS) * (mat == 0 ? 0.08838834764831845f : 1.0f);
#pragma unroll
                    for (int e = 0; e < 8; ++e) s[e] *= rn;
                }
                u32x4 o; o.x = pk2(s[0], s[1]); o.y = pk2(s[2], s[3]); o.z = pk2(s[4], s[5]); o.w = pk2(s[6], s[7]);
                if (mat == 0) {
                    *(u32x4*)(QB + t * 136 + cgi * 8) = o;
                    u32x2 lo, hi; lo.x = pk2(s[0] * eg, s[1] * eg); lo.y = pk2(s[2] * eg, s[3] * eg); hi.x = pk2(s[4] * eg, s[5] * eg); hi.y = pk2(s[6] * eg, s[7] * eg);
                    int qoff = t * 136 + 16 * (cgi >> 1) + 4 * (cgi & 1); asm volatile("" : "+v"(qoff));
                    bf16* dst = o_qd + qoff;
                    *(u32x2*)dst = lo; *(u32x2*)(dst + 8) = hi;
                } else if (mat == 1) {
                    *(u32x4*)(KB + t * 136 + cgi * 8) = o;
                    const float f = bt * eg; u32x4 o2; o2.x = pk2(s[0] * f, s[1] * f); o2.y = pk2(s[2] * f, s[3] * f); o2.z = pk2(s[4] * f, s[5] * f); o2.w = pk2(s[6] * f, s[7] * f);
                    *(u32x4*)(RHS + t * 264 + 128 + cgi * 8) = o2;
                } else {
                    u32x4 o2; o2.x = pk2(s[0] * bt, s[1] * bt); o2.y = pk2(s[2] * bt, s[3] * bt); o2.z = pk2(s[4] * bt, s[5] * bt); o2.w = pk2(s[6] * bt, s[7] * bt);
                    *(u32x4*)(RHS + t * 264 + cgi * 8) = o2;
                }
            }
        }
    LBAR(); }
    for (int rep_ = 0; rep_ < REPS2; ++rep_) {
        const int which = wv >> 2, ti = (wv >> 1) & 1, tj = wv & 1, r = lane & 31, hh = lane >> 5;
        if (ti == 0 && tj == 1) {
            if (which == 0) {
                const int J = 32 + r;
#pragma unroll
                for (int i = 0; i < 16; ++i) AMD[(J & 1) * 2300 + crow(i, hh) * 36 + (J >> 1)] = 0.f;
            }
        } else {
            const bf16* Ab = (which ? QB : KB) + (32 * ti + r) * 136 + 8 * hh; const bf16* Bb = KB + (32 * tj + r) * 136 + 8 * hh;
            f32x16 acc; for (int i = 0; i < 16; ++i) acc[i] = 0.f;
#pragma unroll
            for (int ks = 0; ks < 8; ++ks) { const bf16x8 av = *(const bf16x8*)(Ab + 16 * ks); const bf16x8 bv = *(const bf16x8*)(Bb + 16 * ks); acc = MFMA32(av, bv, acc); }
            const int J = 32 * tj + r; const float gj = GC[J];
            int koff = (J & ~15) + perm16(J & 15); asm volatile("" : "+v"(koff));
#pragma unroll
            for (int i = 0; i < 16; ++i) {
                const int I = 32 * ti + crow(i, hh); const float gi = GC[I];
                if (which == 0) AMD[(J & 1) * 2300 + I * 36 + (J >> 1)] = (J < I) ? BETA[I] * acc[i] * __expf(gi - gj) : 0.f;
                else o_qk[I * 72 + koff] = f2bf((J <= I) ? acc[i] * __expf(gi - gj) : 0.f);
            }
        }
    LBAR(); }
    {
        const float gcl = GC[63];
        u32x4 nx[7]; int nh = 0, nb = 0, np0 = 0;
        if (next >= 0) { nh = next & 7; const int nbc = next >> 3; np0 = (nbc % NCH) * 64 - 48; nb = nbc / NCH;
#pragma unroll
            for (int k = 0; k < 7; ++k) { const int idx = min(tid + 512 * k, 67 * 48 - 1); const int rr = idx / 48, ch = idx % 48, mat = ch >> 4, cc = ch & 15, p = np0 + rr - 3;
                nx[k] = *(const u32x4*)((const bf16*)(a.ws + WS_PROJ) + (size_t)row_of(nb, max(p, 0)) * PROJ_LD + mat * 1024 + nh * 128 + cc * 8); if (p < 0) nx[k] = (u32x4){0u, 0u, 0u, 0u}; } }
#pragma unroll
        for (int q = 0; q < 2; ++q) {
            const int idx = tid + 512 * q, dk = idx >> 3, oct = idx & 7, G16 = oct >> 1, f = oct & 1;
            float v[8];
#pragma unroll
            for (int jj = 0; jj < 8; ++jj) { const int t = 16 * G16 + 8 * (jj >> 2) + 4 * f + (jj & 3); v[jj] = bf2f(KB[t * 136 + dk]) * __expf(gcl - GC[t]); }
            u32x4 o; o.x = pk2(v[0], v[1]); o.y = pk2(v[2], v[3]); o.z = pk2(v[4], v[5]); o.w = pk2(v[6], v[7]);
            *(u32x4*)(o_kdT + dk * 72 + 8 * oct) = o;
        }
        if (next >= 0) {
#pragma unroll
            for (int k = 0; k < 7; ++k) { const int idx = tid + 512 * k; if (idx < 67 * 48) { const int rr = idx / 48, ch = idx % 48; *(u32x4*)(RAW + rr * 392 + (ch >> 4) * 128 + (ch & 15) * 8) = nx[k]; } }
        }
        if (next >= 0 && wv == 7) gdn_gates(a, (float*)(lds + 140288) + 128 * (par ^ 1), next, lane);
        if (wv < 4) {
            const int cp = tid >> 1, hf = tid & 1;
            int zoff; asm volatile("v_mov_b32 %0, 0" : "=v"(zoff));
            const float* AMh = AMD + hf * 2300 + zoff;
            f32x2_t xh[32];
#pragma unroll
            for (int q = 0; q < 32; ++q) xh[q] = (f32x2_t){0.f, 0.f};
            { const unsigned r0 = *(const unsigned*)(RHS + 2 * cp); if (hf == 0) xh[0] = (f32x2_t){bflo(r0), bfhi(r0)}; }
#pragma unroll
            for (int ii = 0; ii < 31; ++ii) {
                const int i = 2 * ii + 1, j = i + 1;
                f32x4 Ai[8], Aj[8];
#pragma unroll
                for (int r4 = 0; r4 < (ii + 4) / 4; ++r4) { Ai[r4] = *(const f32x4*)(AMh + i * 36 + 4 * r4); Aj[r4] = *(const f32x4*)(AMh + j * 36 + 4 * r4); }
                const unsigned ri = *(const unsigned*)(RHS + i * 264 + 2 * cp), rj = *(const unsigned*)(RHS + j * 264 + 2 * cp);
                const float aji = AMD[2300 + j * 36 + ii + zoff];
                f32x2_t ai[2] = {{0.f, 0.f}, {0.f, 0.f}}, aj[2] = {{0.f, 0.f}, {0.f, 0.f}};
#pragma unroll
                for (int q = 0; q < ii + 1; ++q) { const float vi = Ai[q >> 2][q & 3], vj = Aj[q >> 2][q & 3]; ai[q & 1] += (f32x2_t){vi, vi} * xh[q]; aj[q & 1] += (f32x2_t){vj, vj} * xh[q]; }
                f32x2_t ti = ai[0] + ai[1], tj = aj[0] + aj[1];
                ti.x += xor1(ti.x); ti.y += xor1(ti.y); tj.x += xor1(tj.x); tj.y += xor1(tj.y);
                const f32x2_t xi = (f32x2_t){bflo(ri), bfhi(ri)} - ti;
                const f32x2_t xj = (f32x2_t){bflo(rj), bfhi(rj)} - tj - (f32x2_t){aji, aji} * xi;
                if (hf == 1) xh[ii] = xi; else xh[ii + 1] = xj;
            }
            {
                f32x4 Ac[8];
#pragma unroll
                for (int r4 = 0; r4 < 8; ++r4) Ac[r4] = *(const f32x4*)(AMh + 63 * 36 + 4 * r4);
                const unsigned rr = *(const unsigned*)(RHS + 63 * 264 + 2 * cp);
                f32x2_t acc[2] = {{0.f, 0.f}, {0.f, 0.f}};
#pragma unroll
                for (int q = 0; q < 32; ++q) { const float av = Ac[q >> 2][q & 3]; acc[q & 1] += (f32x2_t){av, av} * xh[q]; }
                f32x2_t tot = acc[0] + acc[1];
                tot.x += xor1(tot.x); tot.y += xor1(tot.y);
                const f32x2_t xi = (f32x2_t){bflo(rr), bfhi(rr)} - tot;
                if (hf == 1) xh[31] = xi;
            }
            f32x2_t ev[16], od[16];
#pragma unroll
            for (int q = 0; q < 16; ++q) { const f32x2_t send = hf ? xh[q] : xh[16 + q]; f32x2_t got; got.x = xor1(send.x); got.y = xor1(send.y); ev[q] = hf ? got : xh[q]; od[q] = hf ? xh[16 + q] : got; }
            if (wv < 2) {
                bf16* dst = o_uT + (2 * cp) * 72 + 32 * hf;
#pragma unroll
                for (int c4 = 0; c4 < 4; ++c4) { u32x4 o0, o1;
                    o0.x = pk2(ev[4 * c4].x, od[4 * c4].x); o0.y = pk2(ev[4 * c4 + 1].x, od[4 * c4 + 1].x); o0.z = pk2(ev[4 * c4 + 2].x, od[4 * c4 + 2].x); o0.w = pk2(ev[4 * c4 + 3].x, od[4 * c4 + 3].x);
                    o1.x = pk2(ev[4 * c4].y, od[4 * c4].y); o1.y = pk2(ev[4 * c4 + 1].y, od[4 * c4 + 1].y); o1.z = pk2(ev[4 * c4 + 2].y, od[4 * c4 + 2].y); o1.w = pk2(ev[4 * c4 + 3].y, od[4 * c4 + 3].y);
                    *(u32x4*)(dst + 8 * c4) = o0; *(u32x4*)(dst + 72 + 8 * c4) = o1; }
            } else {
                const int dk = 2 * cp - 128; unsigned* dst = (unsigned*)(QB + (dk & ~15) + perm16(dk & 15) + 32 * hf * 136);
#pragma unroll
                for (int q = 0; q < 16; ++q) { dst[(2 * q) * 68] = pk2(ev[q].x, ev[q].y); dst[(2 * q + 1) * 68] = pk2(od[q].x, od[q].y); }
            }
        }
        if (tid == 0) *(float*)((unsigned char*)QB + 256) = __expf(gcl);
        LBAR();
#pragma unroll
        for (int k = 0; k < 3; ++k) { const int idx = tid + 512 * k; if (idx < 1088) *(u32x4*)(it + 16 * idx) = *(const u32x4*)((const unsigned char*)QB + 16 * idx); }
        LBAR();
    }
}
DI void p2_gla_item(const Args& a, unsigned char* lds, int item, int tid) {
    const int h = item & 3, bc = item >> 2, c = bc % NCH, b = bc / NCH;
    const int lane = tid & 63, wv = tid >> 6;
    float* LR = (float*)lds;
    bf16* QB = (bf16*)(lds + 4096);
    bf16* KB = (bf16*)(lds + 4096 + 17408);
    bf16* VB = (bf16*)(lds + 4096 + 2 * 17408);
    float* PS = (float*)(lds + 4096 + 2 * 17408 + 33792);
    const bf16* proj = (const bf16*)(a.ws + WS_PROJ); const float* small = (const float*)(a.ws + WS_SMALL);
    unsigned char* it = (unsigned char*)a.out + (size_t)item * GLA_ITEM;
    bf16* o_qt = (bf16*)it; bf16* o_kdT = (bf16*)(it + 17408); bf16* o_sc = (bf16*)(it + 35840); float* o_dec = (float*)(it + 45056); bf16* o_vT = (bf16*)(it + 45568);
    const int p0 = c * 64 - 48;
    bf16 qraw[16], kraw[16];
    { const int d = tid & 127, tq = tid >> 7;
#pragma unroll
      for (int tt = 0; tt < 16; ++tt) { const int p = p0 + 16 * tq + tt; const bf16* rp = proj + (size_t)row_of(b, max(p, 0)) * PROJ_LD + h * 128 + d;
          qraw[tt] = rp[4096]; kraw[tt] = rp[4608]; if (p < 0) { qraw[tt] = 0; kraw[tt] = 0; } } }
    { float lrv[2]; u32x4 vv[4];
#pragma unroll
      for (int k = 0; k < 2; ++k) { const int idx = tid + 512 * k, t = idx >> 4, r = idx & 15, p = p0 + t; lrv[k] = small[(size_t)row_of(b, max(p, 0)) * 32 + 16 + r]; if (p < 0) lrv[k] = 0.f; }
#pragma unroll
      for (int k = 0; k < 4; ++k) { const int idx = tid + 512 * k, t = idx >> 5, cc = idx & 31, p = p0 + t; vv[k] = *(const u32x4*)(proj + (size_t)row_of(b, max(p, 0)) * PROJ_LD + 5120 + h * 256 + cc * 8); if (p < 0) vv[k] = (u32x4){0u, 0u, 0u, 0u}; }
#pragma unroll
      for (int k = 0; k < 2; ++k) LR[tid + 512 * k] = lrv[k];
#pragma unroll
      for (int k = 0; k < 4; ++k) { const int idx = tid + 512 * k; *(u32x4*)(VB + (idx >> 5) * 264 + (idx & 31) * 8) = vv[k]; } }
    LBAR();
    {
        const int d = tid & 127, tq = tid >> 7;
        float w2r[16];
#pragma unroll
        for (int r = 0; r < 16; ++r) w2r[r] = a.in[8][r * 512 + h * 128 + d];
        const float bias = a.in[9][h * 128 + d];
        float cs[16]; float run = 0.f;
#pragma unroll
        for (int tt = 0; tt < 16; ++tt) {
            const int t = 16 * tq + tt; float z = bias;
#pragma unroll
            for (int r4 = 0; r4 < 4; ++r4) { const f32x4 l4 = *(const f32x4*)(LR + t * 16 + 4 * r4); z += l4.x * w2r[4 * r4] + l4.y * w2r[4 * r4 + 1] + l4.z * w2r[4 * r4 + 2] + l4.w * w2r[4 * r4 + 3]; }
            const float ls = fminf(z, 0.f) - __logf(1.0f + __expf(-fabsf(z)));
            run += ((p0 + t) >= 0) ? ls * (1.f / 16.f) : 0.f; cs[tt] = run;
        }
        PS[tq * 128 + d] = run;
        LBAR();
        float off = 0.f, total = 0.f;
#pragma unroll
        for (int q = 0; q < 4; ++q) { const float v = PS[q * 128 + d]; total += v; if (q < tq) off += v; }
        float kd[16];
#pragma unroll
        for (int tt = 0; tt < 16; ++tt) {
            const int t = 16 * tq + tt; const float bc_ = off + cs[tt];
            const float qv = bf2f(qraw[tt]) * 0.08838834764831845f, kv = bf2f(kraw[tt]);
            const float qt = qv * __expf(bc_), kt = kv * __expf(-bc_); kd[tt] = kv * __expf(total - bc_);
            const bf16 qtb = f2bf(qt);
            QB[t * 136 + d] = qtb; KB[t * 136 + d] = f2bf(kt);
            o_qt[t * 136 + (d & ~15) + perm16(d & 15)] = qtb;
        }
        { bf16* dst = o_kdT + d * 72 + 16 * tq; u32x4 o0, o1;
          o0.x = pk2(kd[0], kd[1]); o0.y = pk2(kd[2], kd[3]); o0.z = pk2(kd[4], kd[5]); o0.w = pk2(kd[6], kd[7]);
          o1.x = pk2(kd[8], kd[9]); o1.y = pk2(kd[10], kd[11]); o1.z = pk2(kd[12], kd[13]); o1.w = pk2(kd[14], kd[15]);
          *(u32x4*)dst = o0; *(u32x4*)(dst + 8) = o1; }
        if (tq == 0) o_dec[d] = __expf(total);
#pragma unroll
        for (int q = 0; q < 4; ++q) { const int idx = tid + 512 * q, dv = idx >> 3, oct = idx & 7; bf16 v[8];
#pragma unroll
            for (int jj = 0; jj < 8; ++jj) v[jj] = VB[(8 * oct + jj) * 264 + dv];
            u32x4 o; o.x = v[0] | ((unsigned)v[1] << 16); o.y = v[2] | ((unsigned)v[3] << 16); o.z = v[4] | ((unsigned)v[5] << 16); o.w = v[6] | ((unsigned)v[7] << 16);
            *(u32x4*)(o_vT + dv * 72 + 8 * oct) = o; }
    }
    LBAR();
    if (wv < 3) {
        const int ti = wv == 0 ? 0 : 1, tj = wv == 2 ? 1 : 0, r = lane & 31, hh = lane >> 5;
        const bf16* Ab = QB + (32 * ti + r) * 136 + 8 * hh; const bf16* Bb = KB + (32 * tj + r) * 136 + 8 * hh;
        f32x16 acc; for (int i = 0; i < 16; ++i) acc[i] = 0.f;
#pragma unroll
        for (int ks = 0; ks < 8; ++ks) { const bf16x8 av = *(const bf16x8*)(Ab + 16 * ks); const bf16x8 bv = *(const bf16x8*)(Bb + 16 * ks); acc = MFMA32(av, bv, acc); }
        const int J = 32 * tj + r;
#pragma unroll
        for (int i = 0; i < 16; ++i) { const int I = 32 * ti + crow(i, hh); o_sc[I * 72 + J] = f2bf((J <= I) ? acc[i] : 0.f); }
    }
    LBAR();
}

DI bf16x8 pack8(const f32x16& x, int s) {
    u32x4 p; p.x = pk2(x[8 * s], x[8 * s + 1]); p.y = pk2(x[8 * s + 2], x[8 * s + 3]); p.z = pk2(x[8 * s + 4], x[8 * s + 5]); p.w = pk2(x[8 * s + 6], x[8 * s + 7]);
    return __builtin_bit_cast(bf16x8, p);
}
#define P3_BAR() do { asm volatile("s_waitcnt lgkmcnt(0)" ::: "memory"); __builtin_amdgcn_s_barrier(); asm volatile("" ::: "memory"); } while (0)
template <bool GDN> DI void p3_scan(const Args& a, unsigned char* lds, int bh, int sl, int tid) {
    constexpr int NSH = GDN ? 3904 : 2848, NTOT = NSH + 288, NPER = (NTOT + 447) / 448, ITEM = GDN ? GDN_ITEM : GLA_ITEM, SLOFF = GDN ? 62464 : 45568, NH = GDN ? 8 : 4;
    const int wave = __builtin_amdgcn_readfirstlane(tid >> 6), lane = tid & 63;
    const int b = bh / NH, h = bh % NH;
    const unsigned char* item0 = (GDN ? a.ws + WS_GDN : (const unsigned char*)a.out) + (size_t)((b * NCH) * NH + h) * ITEM;
    if (wave != 0) {
        const int pt = tid - 64;
        u32x4 R0[NPER], R1[NPER], R2[NPER];
#define P3_ISSUE(R, c_) do { const unsigned char* src_ = item0 + (size_t)(c_) * NH * ITEM; _Pragma("unroll") for (int k = 0; k < NPER; ++k) { const int i = pt + 448 * k; \
            if (i < NTOT) R[k] = *(const u32x4*)(src_ + (i < NSH ? 16 * i : SLOFF + sl * 4608 + 16 * (i - NSH))); } } while (0)
#define P3_COMMIT(R, bi_) do { unsigned char* dst_ = lds + (bi_) * P3_BUF; _Pragma("unroll") for (int k = 0; k < NPER; ++k) { const int i = pt + 448 * k; if (i < NTOT) *(u32x4*)(dst_ + 16 * i) = R[k]; } } while (0)
        P3_ISSUE(R0, 0); P3_COMMIT(R0, 0); P3_ISSUE(R1, 1); P3_ISSUE(R2, 2);
        P3_BAR();
        static_assert(NCH % 3 == 0, "producer loop is unrolled by the three register sets");
        for (int c = 0; c < NCH; c += 3) {
            if (c + 3 < NCH) P3_ISSUE(R0, c + 3);
            P3_COMMIT(R1, (c + 1) & 1);
            P3_BAR();
            if (c + 4 < NCH) P3_ISSUE(R1, c + 4);
            P3_COMMIT(R2, (c + 2) & 1);
            P3_BAR();
            if (c + 5 < NCH) P3_ISSUE(R2, c + 5);
            if (c + 3 < NCH) P3_COMMIT(R0, (c + 3) & 1);
            P3_BAR();
        }
#undef P3_ISSUE
#undef P3_COMMIT
        return;
    }
    const int r = lane & 31, hh = lane >> 5;
    __builtin_amdgcn_s_setprio(3);
    bf16* O = (bf16*)(a.ws + WS_NBUF) + (GDN ? h * 128 : 1024 + h * 256) + 32 * sl + r;
    f32x16 S[4];
#pragma unroll
    for (int m = 0; m < 4; ++m) for (int i = 0; i < 16; ++i) S[m][i] = 0.f;
    P3_BAR();
    for (int c = 0; c < NCH; ++c) {
        const unsigned char* base = lds + (c & 1) * P3_BUF;
        bf16x8 Sp[4][2];
#pragma unroll
        for (int m = 0; m < 4; ++m) { Sp[m][0] = pack8(S[m], 0); Sp[m][1] = pack8(S[m], 1); }
        f32x16 QS[2];
        bf16x8 Vp[2][2];
        const unsigned char* qp = base + (GDN ? 17408 : 0) + r * 272 + 16 * hh; const unsigned char* sp = base + (GDN ? 53248 : 35840) + r * 144 + 16 * hh;
#define P3_QS1() do { _Pragma("unroll") for (int mt = 0; mt < 2; ++mt) { for (int i = 0; i < 16; ++i) QS[mt][i] = 0.f; \
            _Pragma("unroll") for (int m = 0; m < 4; ++m) _Pragma("unroll") for (int s = 0; s < 2; ++s) { const bf16x8 aq = *(const bf16x8*)(qp + mt * 32 * 272 + 32 * (2 * m + s)); QS[mt] = MFMA32(aq, Sp[m][s], QS[mt]); } } } while (0)
        if constexpr (GDN) {
            const unsigned char* wp = base + r * 272 + 16 * hh; const unsigned char* uT = base + 62464 + r * 144 + 8 * hh;
            f32x16 WS[2];
#pragma unroll
            for (int mt = 0; mt < 2; ++mt) { for (int i = 0; i < 16; ++i) WS[mt][i] = 0.f;
#pragma unroll
                for (int m = 0; m < 4; ++m)
#pragma unroll
                    for (int s = 0; s < 2; ++s) { const bf16x8 aw = *(const bf16x8*)(wp + mt * 32 * 272 + 32 * (2 * m + s)); WS[mt] = MFMA32(aw, Sp[m][s], WS[mt]); } }
            P3_QS1();
#pragma unroll
            for (int mt = 0; mt < 2; ++mt) { f32x16 vn;
#pragma unroll
                for (int g = 0; g < 4; ++g) { const u32x2 u4 = *(const u32x2*)(uT + 2 * (32 * mt + 8 * g));
                    vn[4 * g] = bflo(u4.x) - WS[mt][4 * g]; vn[4 * g + 1] = bfhi(u4.x) - WS[mt][4 * g + 1]; vn[4 * g + 2] = bflo(u4.y) - WS[mt][4 * g + 2]; vn[4 * g + 3] = bfhi(u4.y) - WS[mt][4 * g + 3]; }
                Vp[mt][0] = pack8(vn, 0); Vp[mt][1] = pack8(vn, 1); }
        } else {
            const unsigned char* vT = base + 45568 + r * 144 + 16 * hh;
#pragma unroll
            for (int mt2 = 0; mt2 < 2; ++mt2)
#pragma unroll
                for (int s = 0; s < 2; ++s) Vp[mt2][s] = *(const bf16x8*)(vT + 32 * (2 * mt2 + s));
            P3_QS1();
        }
#undef P3_QS1
        SB();
        {
            const unsigned char* kp = base + (GDN ? 34816 : 17408) + r * 144 + 16 * hh;
            float gl = 1.f; if constexpr (GDN) gl = *(const float*)(base + 256);
#pragma unroll
            for (int m = 0; m < 4; ++m) {
                if constexpr (GDN) S[m] = S[m] * gl;
                else {
#pragma unroll
                    for (int g = 0; g < 4; ++g) { const f32x4 d4 = *(const f32x4*)(base + 45056 + 4 * (32 * m + 8 * g + 4 * hh)); S[m][4 * g] *= d4.x; S[m][4 * g + 1] *= d4.y; S[m][4 * g + 2] *= d4.z; S[m][4 * g + 3] *= d4.w; } }
#pragma unroll
                for (int mt2 = 0; mt2 < 2; ++mt2)
#pragma unroll
                    for (int s = 0; s < 2; ++s) { const bf16x8 aa = *(const bf16x8*)(kp + m * 32 * 144 + 32 * (2 * mt2 + s)); S[m] = MFMA32(aa, Vp[mt2][s], S[m]); } }
#pragma unroll
            for (int mt = 0; mt < 2; ++mt)
#pragma unroll
                for (int mt2 = 0; mt2 <= mt; ++mt2)
#pragma unroll
                    for (int s = 0; s < 2; ++s) { const bf16x8 aa = *(const bf16x8*)(sp + mt * 32 * 144 + 32 * (2 * mt2 + s)); QS[mt] = MFMA32(aa, Vp[mt2][s], QS[mt]); }
        }
        if (c > 0) {
            bf16* orow = O + (size_t)(b * SEQ + (c - 1) * 64) * DM;
#pragma unroll
            for (int mt = 0; mt < 2; ++mt)
#pragma unroll
                for (int i = 0; i < 16; ++i) orow[(size_t)(32 * mt + crow(i, hh)) * DM] = f2bf(QS[mt][i]);
        }
        P3_BAR();
    }
    __builtin_amdgcn_s_setprio(0);
}

#define DPPF(v, ctrl) __int_as_float(__builtin_amdgcn_update_dpp(0, __float_as_int(v), (ctrl), 0xF, 0xF, true))
DI float sum16(float v) {
    v += DPPF(v, 0xB1); v += DPPF(v, 0x4E); v += DPPF(v, 0x141); v += DPPF(v, 0x140); return v;
}
DI void p4_rows2(const Args& a, int row, int lane) {
    bf16* O = (bf16*)(a.ws + WS_NBUF) + (size_t)row * DM; const bf16* pr = (const bf16*)(a.ws + WS_PROJ) + (size_t)row * PROJ_LD;
    u32x4 ov[2][4], gv[2][4]; f32x4 wv[4][2];
#pragma unroll
    for (int rr = 0; rr < 2; ++rr)
#pragma unroll
        for (int j = 0; j < 4; ++j) { const int col = 8 * lane + 512 * j;
            ov[rr][j] = *(const u32x4*)(O + (size_t)rr * DM + col);
            gv[rr][j] = *(const u32x4*)(pr + (size_t)rr * PROJ_LD + (j < 2 ? 3072 + col : 6144 + (col - 1024))); }
#pragma unroll
    for (int j = 0; j < 4; ++j) { const int col = 8 * lane + 512 * j; const float* nw = j < 2 ? a.in[7] + (col & 127) : a.in[10] + ((col - 1024) & 255);
        wv[j][0] = *(const f32x4*)nw; wv[j][1] = *(const f32x4*)(nw + 4); }
#pragma unroll
    for (int rr = 0; rr < 2; ++rr)
#pragma unroll
        for (int j = 0; j < 4; ++j) {
            const int col = 8 * lane + 512 * j; const u32x4 o4 = ov[rr][j], g4 = gv[rr][j];
            float o[8] = {bflo(o4.x), bfhi(o4.x), bflo(o4.y), bfhi(o4.y), bflo(o4.z), bfhi(o4.z), bflo(o4.w), bfhi(o4.w)};
            float g[8] = {bflo(g4.x), bfhi(g4.x), bflo(g4.y), bfhi(g4.y), bflo(g4.z), bfhi(g4.z), bflo(g4.w), bfhi(g4.w)};
            float w[8] = {wv[j][0].x, wv[j][0].y, wv[j][0].z, wv[j][0].w, wv[j][1].x, wv[j][1].y, wv[j][1].z, wv[j][1].w};
            float ss = 0.f;
#pragma unroll
            for (int e = 0; e < 8; ++e) ss += o[e] * o[e];
            ss = sum16(ss);
            float rn;
            if (j < 2) rn = rsqrtf(ss * (1.f / 128.f) + EPS);
            else { ss += __shfl_xor(ss, 16); rn = rsqrtf(ss * (1.f / 256.f) + EPS); }
            float y[8];
#pragma unroll
            for (int e = 0; e < 8; ++e) y[e] = o[e] * rn * w[e] * silu_f(g[e]);
            u32x4 res; res.x = pk2(y[0], y[1]); res.y = pk2(y[2], y[3]); res.z = pk2(y[4], y[5]); res.w = pk2(y[6], y[7]);
            *(u32x4*)(O + (size_t)rr * DM + col) = res;
        }
}

#define LAS __attribute__((address_space(3)))
#define XB_TMO      128
#define XB_XCNT(j)  (256  + 64 * (j))
#define XB_XSUB(j)  (1280 + 64 * (j))
#define XB_XGEN(j)  (2304 + 64 * (j))
#define XB_TOP      3328
#define XB_TOPGEN   3392
#define XCD_BAR_WORDS 3456
#define XB_SPIN_CAP (1u << 18)

__device__ __forceinline__ unsigned xb_ld(unsigned* p)              { return __hip_atomic_load(p, __ATOMIC_RELAXED, __HIP_MEMORY_SCOPE_AGENT); }
__device__ __forceinline__ unsigned xb_add(unsigned* p, unsigned v) { return __hip_atomic_fetch_add(p, v, __ATOMIC_RELAXED, __HIP_MEMORY_SCOPE_AGENT); }
__device__ __forceinline__ unsigned xb_xcc_id() { return (unsigned)__builtin_amdgcn_s_getreg((3 << 11) | 20) & 0xFu; }
#define XB_SPIN(cond, bar) do { unsigned _sp = 0; while (cond) { __builtin_amdgcn_s_sleep(1); \
    if ((++_sp & 255u) == 0u) { if (xb_ld(&(bar)[XB_TMO])) break; if (_sp > XB_SPIN_CAP) { atomicAdd(&(bar)[XB_TMO], 1u); break; } } } } while (0)

struct XcdBarrier {
    unsigned* bar; unsigned x;
    volatile LAS unsigned* st;
};

__device__ __forceinline__ XcdBarrier xcd_barrier_post(unsigned* bar, volatile LAS unsigned* st) {
    XcdBarrier b; b.bar = bar; b.x = xb_xcc_id(); b.st = st;
    if (threadIdx.x == 0) (void)xb_add(&bar[XB_XCNT(b.x)], 1u);
    return b;
}
__device__ __forceinline__ void xcd_barrier_complete(unsigned* bar, unsigned x, unsigned& nloc, unsigned& nx) {
    const unsigned G = gridDim.x * gridDim.y * gridDim.z;
    unsigned sum, cnt, mine, sp = 0u;
    for (;;) {
        sum = 0u; cnt = 0u; mine = 0u;
#pragma unroll
        for (unsigned j = 0; j < 16; ++j) { const unsigned c = xb_ld(&bar[XB_XCNT(j)]); sum += c; cnt += (c > 0u) ? 1u : 0u; mine = (j == x) ? c : mine; }
        if (sum == G) break;
        __builtin_amdgcn_s_sleep(1);
        if ((++sp & 255u) == 0u) { if (xb_ld(&bar[XB_TMO])) break; if (sp > XB_SPIN_CAP) { atomicAdd(&bar[XB_TMO], 1u); break; } }
    }
    nloc = mine > 0u ? mine : 1u; nx = cnt > 0u ? cnt : 1u;
}

__device__ __forceinline__ void xcd_barrier(const XcdBarrier& b) {
    asm volatile("s_waitcnt vmcnt(0)" ::: "memory");
    __syncthreads();
    if (threadIdx.x == 0) {
        unsigned* bar = b.bar;
        __builtin_amdgcn_s_waitcnt(0);
        unsigned nloc = b.st[0], nx = b.st[1];
        if (nloc == 0u) { xcd_barrier_complete(bar, b.x, nloc, nx); b.st[0] = nloc; b.st[1] = nx; }
        const unsigned old = xb_add(&bar[XB_XSUB(b.x)], 1u);
        const unsigned gen = old / nloc;
        if (old + 1u == (gen + 1u) * nloc) {
            __builtin_amdgcn_fence(__ATOMIC_RELEASE, "agent");
            asm volatile("s_waitcnt vmcnt(0)" ::: "memory");
            const unsigned og = xb_add(&bar[XB_TOP], 1u);
            const unsigned tg = og / nx;
            if (og + 1u == (tg + 1u) * nx) xb_add(&bar[XB_TOPGEN], 1u);
            else XB_SPIN(xb_ld(&bar[XB_TOPGEN]) == tg, bar);
            __builtin_amdgcn_fence(__ATOMIC_ACQUIRE, "agent");
            xb_add(&bar[XB_XGEN(b.x)], 1u);
            asm volatile("s_waitcnt vmcnt(0)" ::: "memory");
        } else {
            XB_SPIN(xb_ld(&bar[XB_XGEN(b.x)]) == gen, bar);
            __builtin_amdgcn_fence(__ATOMIC_ACQUIRE, "agent");
            asm volatile("s_waitcnt vmcnt(0)" ::: "memory");
        }
    }
    __syncthreads();
}

__global__ void __launch_bounds__(512, 2) mk_fwd(Args a) {
    extern __shared__ __attribute__((aligned(16))) unsigned char lds[];
    cg::grid_group grid = cg::this_grid();
    const int tid = threadIdx.x, lane = tid & 63, wave = __builtin_amdgcn_readfirstlane(tid >> 6), G = gridDim.x, bx = blockIdx.x;
    const int gw = bx * 8 + wave, NGW = G * 8;
    unsigned char* ws = a.ws;
    PG8_LAS unsigned char* ring = (PG8_LAS unsigned char*)lds;
    const int lo = a.ph_lo, hi = a.ph_hi;
#ifndef SKIPMASK
#define SKIPMASK 0
#endif
#define IN(k) (!((SKIPMASK >> (k)) & 1) && lo <= (k) && (k) < hi)
#ifndef REP2
#define REP2 1
#endif
#ifndef REP3
#define REP3 1
#endif
#ifndef REP7
#define REP7 1
#endif
#define SEAM(k) do { if (IN(k) && IN((k) + 1)) xcd_barrier(bar); } while (0)
#ifdef XSYNC
    for (int q_ = 0; q_ < XSYNC; ++q_) grid.sync();
#endif
#ifdef REP0
    if (IN(0)) p0_prep(a, lds, tid, G);
    __syncthreads();
#endif
    volatile LAS unsigned* bst = (volatile LAS unsigned*)((LAS unsigned char*)lds + 147456);
    if (tid == 0) { bst[0] = 0u; bst[1] = 0u; }
    __syncthreads();
    if (IN(0)) p0_prep(a, lds, tid, G);
    if (bx == 0) { unsigned* bw = (unsigned*)(ws + WS_GL); for (int i = tid; i < XCD_BAR_WORDS; i += 512) bw[i] = 0u; }
    grid.sync();
    XcdBarrier bar = xcd_barrier_post((unsigned*)(ws + WS_GL), bst);
    if (IN(1)) {
        pg8::Gemm g{(const pg8::bf16_t*)(ws + WS_NBUF), (const pg8::bf16_t*)(ws + WS_WIN), MX, PROJ_LD, DM}; pg8::StaticOrder S; S.init(MX, PROJ_LD, G, bx);
        pg8::EpiProj E{(pg8::bf16_t*)(ws + WS_PROJ), (float*)(ws + WS_SMALL)};
        pg8::gemm_phase<pg8::EpiProj, pg8::StaticOrder, true, true>(ring, g, S, E);
        p1_tail(a, lds, tid, bx, G);
    }
    SEAM(1);
    if (IN(2)) {
        { const int h0 = bx & 7; float* cwl = (float*)(lds + 141312); for (int i = tid; i < 4 * 384; i += 512) { const int tap = i / 384, ch = i % 384; cwl[i] = a.in[4][tap * 3072 + (ch >> 7) * 1024 + h0 * 128 + (ch & 127)]; } }
        if (bx < 4128) { gdn_stage_raw(a, lds, bx, tid, 512); if (wave == 0) gdn_gates(a, (float*)(lds + 140288), bx, lane); }
        LBAR();
        { int par = 0; for (int it = bx; it < 4128; it += G, par ^= 1) {
            if ((G & 7) && it != bx) { LBAR(); const int h0 = it & 7; float* cwl = (float*)(lds + 141312); for (int i = tid; i < 4 * 384; i += 512) { const int tap = i / 384, ch = i % 384; cwl[i] = a.in[4][tap * 3072 + (ch >> 7) * 1024 + h0 * 128 + (ch & 127)]; } LBAR(); }
            p2_gdn_item(a, lds, it, it + G < 4128 ? it + G : -1, par, tid); } }
        for (int it = G - 1 - bx; it < 2064; it += G) p2_gla_item(a, lds, it, tid);
#ifdef REPGLA
        for (int it = G - 1 - bx; it < 2064; it += G) p2_gla_item(a, lds, it, tid);
#endif
    }
#if REP2 > 1
    __syncthreads();
    if (IN(2)) {
        { const int h0 = bx & 7; float* cwl = (float*)(lds + 141312); for (int i = tid; i < 4 * 384; i += 512) { const int tap = i / 384, ch = i % 384; cwl[i] = a.in[4][tap * 3072 + (ch >> 7) * 1024 + h0 * 128 + (ch & 127)]; } }
        if (bx < 4128) { gdn_stage_raw(a, lds, bx, tid, 512); if (wave == 0) gdn_gates(a, (float*)(lds + 140288), bx, lane); }
        LBAR();
        { int par = 0; for (int it = bx; it < 4128; it += G, par ^= 1) {
            if ((G & 7) && it != bx) { LBAR(); const int h0 = it & 7; float* cwl = (float*)(lds + 141312); for (int i = tid; i < 4 * 384; i += 512) { const int tap = i / 384, ch = i % 384; cwl[i] = a.in[4][tap * 3072 + (ch >> 7) * 1024 + h0 * 128 + (ch & 127)]; } LBAR(); }
            p2_gdn_item(a, lds, it, it + G < 4128 ? it + G : -1, par, tid); } }
        for (int it = G - 1 - bx; it < 2064; it += G) p2_gla_item(a, lds, it, tid);
    }
#endif
    SEAM(2);
    if (IN(3)) {
        for (int u = bx; u < 256; u += G) {
            const int x = u & 7, j = u >> 3;
            if (j < 16) p3_scan<true>(a, lds, 4 * x + (j >> 2), j & 3, tid);
            else p3_scan<false>(a, lds, 2 * x + ((j - 16) >> 3), (j - 16) & 7, tid);
            __syncthreads();
        }
    }
#if REP3 > 1
    __syncthreads();
    if (IN(3)) {
        for (int u = bx; u < 256; u += G) {
            const int x = u & 7, j = u >> 3;
            if (j < 16) p3_scan<true>(a, lds, 4 * x + (j >> 2), j & 3, tid);
            else p3_scan<false>(a, lds, 2 * x + ((j - 16) >> 3), (j - 16) & 7, tid);
            __syncthreads();
        }
    }
#endif
    SEAM(3);
    if (IN(4)) for (int row = 2 * gw; row < MX; row += 2 * NGW) p4_rows2(a, row, lane);
    SEAM(4);
    if (IN(5)) {
        pg8::Gemm g{(const pg8::bf16_t*)(ws + WS_NBUF), (const pg8::bf16_t*)(ws + WS_WOUT), MX, DM, DM}; pg8::StaticOrder S; S.init(MX, DM, G, bx);
        pg8::EpiResF2B E{a.in[0], (pg8::bf16_t*)(ws + WS_GDN), (float*)(ws + WS_SMALL)};
        pg8::gemm_phase<pg8::EpiResF2B, pg8::StaticOrder, true, true>(ring, g, S, E);
    }
    SEAM(5);
    if (IN(6)) for (int row = bx * 512 + tid; row < MX; row += G * 512) {
        const f32x4* pp = (const f32x4*)(ws + WS_SMALL) + (size_t)row * 8; float t = 0.f;
#pragma unroll
        for (int j = 0; j < 8; ++j) { const f32x4 v = pp[j]; t += (v.x + v.y) + (v.z + v.w); }
        ((float*)(ws + WS_GL + 65536))[row] = rsqrtf(t * (1.f / DM) + EPS);
    }
    SEAM(6);
    if (IN(7)) {
        pg8::Gemm g{(const pg8::bf16_t*)(ws + WS_GDN), (const pg8::bf16_t*)(ws + WS_WGU), MX, 2 * DFF, DM}; pg8::StaticOrder S; S.init(MX, 2 * DFF, G, bx);
        pg8::EpiSwiGLUr E{(pg8::bf16_t*)(ws + WS_PROJ), (const float*)(ws + WS_GL + 65536)};
        pg8::gemm_phase<pg8::EpiSwiGLUr, pg8::StaticOrder, true, true>(ring, g, S, E);
    }
#if REP7 > 1
    __syncthreads();
    if (IN(7)) {
        pg8::Gemm g{(const pg8::bf16_t*)(ws + WS_GDN), (const pg8::bf16_t*)(ws + WS_WGU), MX, 2 * DFF, DM}; pg8::StaticOrder S; S.init(MX, 2 * DFF, G, bx);
        pg8::EpiSwiGLUr E{(pg8::bf16_t*)(ws + WS_PROJ), (const float*)(ws + WS_GL + 65536)};
        pg8::gemm_phase<pg8::EpiSwiGLUr, pg8::StaticOrder, true, true>(ring, g, S, E);
    }
#endif
    SEAM(7);
    if (IN(8)) {
        pg8::Gemm g{(const pg8::bf16_t*)(ws + WS_PROJ), (const pg8::bf16_t*)(ws + WS_WDN), MX, DM, DFF}; pg8::StaticOrder S; S.init(MX, DM, G, bx);
        pg8::EpiResB2B E{(const pg8::bf16_t*)(ws + WS_GDN), (pg8::bf16_t*)(ws + WS_NBUF)};
        pg8::gemm_phase<pg8::EpiResB2B, pg8::StaticOrder, true, true>(ring, g, S, E);
    }
    SEAM(8);
    if (IN(9)) for (int row = 2 * gw; row < MX; row += 2 * NGW) rms_rows2_b2f((const bf16*)(ws + WS_NBUF) + (size_t)row * DM, (const bf16*)(ws + WS_NBUF) + (size_t)(row + 1) * DM, a.in[16], a.out + (size_t)row * DM, a.out + (size_t)(row + 1) * DM, lane);
#undef IN
#undef SEAM
}

extern "C" void kernel_launch(void* const* d_in, const int* in_sizes, int n_in, void* d_out, int out_size, void* d_ws, size_t ws_size, hipStream_t stream) {
    static int grid = 0;
    if (grid == 0) {
        int dev = 0, cus = 0, per_cu = 0;
        if (n_in != 17 || out_size != MX * DM || ws_size < WS_END) { fprintf(stderr, "kernel_launch: unexpected shapes (n_in %d out %d ws %zu)\n", n_in, out_size, ws_size); grid = -1; return; }
        (void)hipGetDevice(&dev);
        (void)hipDeviceGetAttribute(&cus, hipDeviceAttributeMultiprocessorCount, dev);
        (void)hipFuncSetAttribute((const void*)mk_fwd, hipFuncAttributeMaxDynamicSharedMemorySize, LDS_BYTES);
        (void)hipOccupancyMaxActiveBlocksPerMultiprocessor(&per_cu, (const void*)mk_fwd, 512, LDS_BYTES);
        if (per_cu < 1) per_cu = 1;
        grid = cus * per_cu;
    }
    if (grid < 0) return;
    Args a{};
    for (int i = 0; i < 17; ++i) a.in[i] = (const float*)d_in[i];
    a.out = (float*)d_out; a.ws = (unsigned char*)d_ws; a.ph_lo = 0; a.ph_hi = 10;
    void* args[] = {&a};
    hipError_t e = hipLaunchCooperativeKernel((const void*)mk_fwd, dim3(grid), dim3(512), args, LDS_BYTES, stream);
    if (e != hipSuccess) fprintf(stderr, "cooperative launch failed: %s (grid %d)\n", hipGetErrorString(e), grid);
}
```
